# Optimizing an MI355X kernel written in HIP

```python
import jax, jax.numpy as jnp
from jax import lax
import numpy as np

D_MODEL = 1024
BATCH = 8
SEQ = 2048
DEPTH = 2
DEC_BATCH = 128
DEC_SEQ = 4
PAST_LEN = 16384
PAGE_SIZE = 128

N_META = 16
D_MIX = D_MODEL
D_MLSTM = D_MIX // 2
D_LRU = D_MIX - D_MLSTM
MLSTM_HEADS = 4
MLSTM_HEAD_DIM = D_MLSTM // MLSTM_HEADS
LRU_BLOCKS = 8
LRU_BLOCK_DIM = D_LRU // LRU_BLOCKS
CONV_WIDTH = 4
LRU_C = 8.0
CHUNK = 64
D_FF = ((8 * D_MODEL // 3 + 127) // 128) * 128
EPS = 1e-6
SPLITS = [D_MLSTM, 2 * D_MLSTM, 3 * D_MLSTM, 4 * D_MLSTM, 4 * D_MLSTM + MLSTM_HEADS,
          4 * D_MLSTM + 2 * MLSTM_HEADS, 4 * D_MLSTM + 2 * MLSTM_HEADS + D_LRU]
D_IN = 4 * D_MLSTM + 2 * MLSTM_HEADS + 2 * D_LRU

kernel_name = "hymba_mlstm_rglru_macaron_step"


def rmsnorm(x, g):
    xf = x.astype(jnp.float32)
    y = xf * lax.rsqrt(jnp.mean(xf * xf, axis=-1, keepdims=True) + EPS) * g.astype(jnp.float32)
    return y.astype(x.dtype)


def swiglu(x, w_gate, w_up, w_down):
    return (jax.nn.silu(x @ w_gate) * (x @ w_up)) @ w_down


def mlstm_chunk(q, k, v, ig, logf, C0, n0, m0):
    L = q.shape[2]
    b = jnp.cumsum(logf, axis=-1)
    causal = jnp.tril(jnp.ones((L, L), dtype=bool))
    D = jnp.where(causal, b[..., :, None] - b[..., None, :] + ig[..., None, :], -jnp.inf)
    inter = b + m0[..., None]
    m = jnp.maximum(jnp.max(D, axis=-1), inter)
    w_intra = jnp.exp(D - m[..., None])
    w_inter = jnp.exp(inter - m)
    s = jnp.einsum('bhtd,bhsd->bhts', q, k) * w_intra
    num = jnp.einsum('bhts,bhse->bhte', s, v) + w_inter[..., None] * jnp.einsum('bhed,bhtd->bhte', C0, q)
    den = jnp.sum(s, axis=-1) + w_inter * jnp.einsum('bhd,bhtd->bht', n0, q)
    h = num / jnp.maximum(jnp.abs(den), jnp.exp(-m))[..., None]
    m_last = m[..., -1]
    w_state = jnp.exp(b[..., -1:] - b + ig - m_last[..., None])
    decay = jnp.exp(inter[..., -1] - m_last)
    C = decay[..., None, None] * C0 + jnp.einsum('bhs,bhse,bhsd->bhed', w_state, v, k)
    n = decay[..., None] * n0 + jnp.einsum('bhs,bhsd->bhd', w_state, k)
    return h, (C, n, m_last)


def mlstm_prompt(q, k, v, ig, logf):
    B, H, T, dh = q.shape
    C0 = jnp.zeros((B, H, dh, dh), jnp.float32)
    n0 = jnp.zeros((B, H, dh), jnp.float32)
    m0 = jnp.zeros((B, H), jnp.float32)
    h_meta, state = mlstm_chunk(q[:, :, :N_META], k[:, :, :N_META], v[:, :, :N_META],
                                ig[:, :, :N_META], logf[:, :, :N_META], C0, n0, m0)
    n_chunks = (T - N_META) // CHUNK

    def blocks(a):
        r = a[:, :, N_META:]
        return jnp.moveaxis(r.reshape(r.shape[:2] + (n_chunks, CHUNK) + r.shape[3:]), 2, 0)

    def step(carry, xs):
        h, carry = mlstm_chunk(*xs, *carry)
        return carry, h

    state, hs = lax.scan(step, state, (blocks(q), blocks(k), blocks(v), blocks(ig), blocks(logf)))
    hs = jnp.moveaxis(hs, 0, 2).reshape(B, H, T - N_META, dh)
    return jnp.concatenate([h_meta, hs], axis=2), state


def linear_scan_combine(left, right):
    a_l, b_l = left
    a_r, b_r = right
    return a_l * a_r, a_r * b_l + b_r


def mixer(u, W, l, st):
    f32 = jnp.float32
    B, T, _ = u.shape
    H, dh = MLSTM_HEADS, MLSTM_HEAD_DIM
    z = u @ W['w_in'][l]
    q, k, v, o, ig, fg, xr, yg = jnp.split(z, SPLITS, axis=-1)

    def heads(a):
        return a.astype(f32).reshape(B, T, H, dh).transpose(0, 2, 1, 3)

    q = heads(q)
    k = heads(k) * (dh ** -0.5)
    v = heads(v)
    gates = jnp.concatenate([ig, fg], axis=-1).astype(f32) + W['b_gates'][l].astype(f32)
    ig = gates[..., :H].transpose(0, 2, 1)
    logf = jax.nn.log_sigmoid(gates[..., H:]).transpose(0, 2, 1)
    if st is None:
        h, (C, n, m) = mlstm_prompt(q, k, v, ig, logf)
        conv_buf = jnp.zeros((B, CONV_WIDTH - 1, D_LRU), f32)
        h0 = jnp.zeros((B, D_LRU), f32)
    else:
        C0, n0, m0, h0, conv_buf = (s.astype(f32) for s in st)
        h, (C, n, m) = mlstm_chunk(q, k, v, ig, logf, C0, n0, m0)
    h = h.transpose(0, 2, 1, 3)
    h = h * lax.rsqrt(jnp.mean(h * h, axis=-1, keepdims=True) + EPS) * W['g_mlstm_out'][l].astype(f32).reshape(H, dh)
    h_m = (jax.nn.sigmoid(o.astype(f32)).reshape(B, T, H, dh) * h).reshape(B, T, D_MLSTM)

    cw = W['conv_w'][l].astype(f32)
    xp = jnp.concatenate([conv_buf, xr.astype(f32)], axis=1)
    xc = W['conv_b'][l].astype(f32) + sum(xp[:, j:j + T] * cw[j] for j in range(CONV_WIDTH))
    new_buf = xp[:, T:]
    xb = xc.reshape(B, T, LRU_BLOCKS, LRU_BLOCK_DIM)
    r = jax.nn.sigmoid(jnp.einsum('btnd,nde->btne', xb, W['w_rg_a'][l].astype(f32)).reshape(B, T, D_LRU)
                       + W['b_rg_a'][l].astype(f32))
    i = jax.nn.sigmoid(jnp.einsum('btnd,nde->btne', xb, W['w_rg_x'][l].astype(f32)).reshape(B, T, D_LRU)
                       + W['b_rg_x'][l].astype(f32))
    log_a = -LRU_C * r * jax.nn.softplus(-W['lru_lambda'][l].astype(f32))
    a = jnp.exp(log_a)
    b_in = jnp.sqrt(-jnp.expm1(2.0 * log_a)) * (i * xc)
    A, Hc = lax.associative_scan(linear_scan_combine, (a, b_in), axis=1)
    h_l = Hc + A * h0[:, None]
    new_h = h_l[:, -1]
    h_l = h_l * lax.rsqrt(jnp.mean(h_l * h_l, axis=-1, keepdims=True) + EPS) * W['g_lru_out'][l].astype(f32)
    y_l = h_l * jax.nn.gelu(yg.astype(f32))

    mix = jnp.concatenate([h_m, y_l], axis=-1).astype(u.dtype) @ W['w_out'][l]
    return mix, (C, n, m, new_h, new_buf)


def trunk(x, W, states):
    collected = ([], [], [], [], [])
    for l in range(DEPTH):
        x = x + 0.5 * swiglu(rmsnorm(x, W['g_ff1'][l]), W['w_ff1_gate'][l], W['w_ff1_up'][l], W['w_ff1_down'][l])
        st = None if states is None else tuple(s[l] for s in states)
        mix, new_st = mixer(rmsnorm(x, W['g_mix'][l]), W, l, st)
        x = x + mix
        x = x + 0.5 * swiglu(rmsnorm(x, W['g_ff2'][l]), W['w_ff2_gate'][l], W['w_ff2_up'][l], W['w_ff2_down'][l])
        for lst, s in zip(collected, new_st):
            lst.append(s.astype(x.dtype))
    y = rmsnorm(x, W['g_final'])
    return y, tuple(jnp.stack(lst) for lst in collected)


def setup_inputs(seed: int = 0) -> dict:
    key = jax.random.key(seed)
    ks = jax.random.split(key, 40)
    f32 = jnp.float32

    def nrm(k, shape, scale):
        return jax.random.normal(k, shape, f32) * scale

    H, dh = MLSTM_HEADS, MLSTM_HEAD_DIM
    a_c = jax.random.uniform(ks[0], (DEPTH, D_LRU), f32, minval=0.9, maxval=0.999)
    s = a_c ** (1.0 / LRU_C)
    lru_lambda = jnp.log(s) - jnp.log1p(-s)
    b_gates = jnp.concatenate([nrm(ks[1], (DEPTH, H), 0.1),
                               3.0 + 3.0 * jax.random.uniform(ks[2], (DEPTH, H), f32)], axis=-1)
    return {
        'x_prompt': nrm(ks[3], (BATCH, SEQ, D_MODEL), 1.0),
        'x_sample': nrm(ks[4], (DEC_BATCH, DEC_SEQ, D_MODEL), 1.0),
        'state_mlstm_C': nrm(ks[5], (DEPTH, DEC_BATCH, H, dh, dh), 0.1),
        'state_mlstm_n': nrm(ks[6], (DEPTH, DEC_BATCH, H, dh), 0.5),
        'state_mlstm_m': nrm(ks[7], (DEPTH, DEC_BATCH, H), 1.0),
        'state_lru_h': nrm(ks[8], (DEPTH, DEC_BATCH, D_LRU), 0.5),
        'state_conv': nrm(ks[9], (DEPTH, DEC_BATCH, CONV_WIDTH - 1, D_LRU), 1.0),
        'meta_tokens': nrm(ks[10], (N_META, D_MODEL), 1.0),
        'g_ff1': 1.0 + nrm(ks[11], (DEPTH, D_MODEL), 0.02),
        'w_ff1_gate': nrm(ks[12], (DEPTH, D_MODEL, D_FF), D_MODEL ** -0.5),
        'w_ff1_up': nrm(ks[13], (DEPTH, D_MODEL, D_FF), D_MODEL ** -0.5),
        'w_ff1_down': nrm(ks[14], (DEPTH, D_FF, D_MODEL), D_FF ** -0.5),
        'g_mix': 1.0 + nrm(ks[15], (DEPTH, D_MODEL), 0.02),
        'w_in': nrm(ks[16], (DEPTH, D_MODEL, D_IN), D_MODEL ** -0.5),
        'b_gates': b_gates,
        'conv_w': nrm(ks[17], (DEPTH, CONV_WIDTH, D_LRU), CONV_WIDTH ** -0.5),
        'conv_b': nrm(ks[18], (DEPTH, D_LRU), 0.02),
        'w_rg_a': nrm(ks[19], (DEPTH, LRU_BLOCKS, LRU_BLOCK_DIM, LRU_BLOCK_DIM), LRU_BLOCK_DIM ** -0.5),
        'b_rg_a': nrm(ks[20], (DEPTH, D_LRU), 0.02),
        'w_rg_x': nrm(ks[21], (DEPTH, LRU_BLOCKS, LRU_BLOCK_DIM, LRU_BLOCK_DIM), LRU_BLOCK_DIM ** -0.5),
        'b_rg_x': nrm(ks[22], (DEPTH, D_LRU), 0.02),
        'lru_lambda': lru_lambda,
        'g_mlstm_out': 1.0 + nrm(ks[23], (DEPTH, D_MLSTM), 0.02),
        'g_lru_out': 1.0 + nrm(ks[24], (DEPTH, D_LRU), 0.02),
        'w_out': nrm(ks[25], (DEPTH, D_MIX, D_MODEL), D_MIX ** -0.5),
        'g_ff2': 1.0 + nrm(ks[26], (DEPTH, D_MODEL), 0.02),
        'w_ff2_gate': nrm(ks[27], (DEPTH, D_MODEL, D_FF), D_MODEL ** -0.5),
        'w_ff2_up': nrm(ks[28], (DEPTH, D_MODEL, D_FF), D_MODEL ** -0.5),
        'w_ff2_down': nrm(ks[29], (DEPTH, D_FF, D_MODEL), D_FF ** -0.5),
        'g_final': 1.0 + nrm(ks[30], (D_MODEL,), 0.02),
    }


def reference(x_prompt, x_sample, state_mlstm_C, state_mlstm_n, state_mlstm_m, state_lru_h, state_conv,
              meta_tokens, g_ff1, w_ff1_gate, w_ff1_up, w_ff1_down, g_mix, w_in, b_gates, conv_w, conv_b,
              w_rg_a, b_rg_a, w_rg_x, b_rg_x, lru_lambda, g_mlstm_out, g_lru_out, w_out,
              g_ff2, w_ff2_gate, w_ff2_up, w_ff2_down, g_final):
    W = dict(g_ff1=g_ff1, w_ff1_gate=w_ff1_gate, w_ff1_up=w_ff1_up, w_ff1_down=w_ff1_down,
             g_mix=g_mix, w_in=w_in, b_gates=b_gates, conv_w=conv_w, conv_b=conv_b,
             w_rg_a=w_rg_a, b_rg_a=b_rg_a, w_rg_x=w_rg_x, b_rg_x=b_rg_x, lru_lambda=lru_lambda,
             g_mlstm_out=g_mlstm_out, g_lru_out=g_lru_out, w_out=w_out,
             g_ff2=g_ff2, w_ff2_gate=w_ff2_gate, w_ff2_up=w_ff2_up, w_ff2_down=w_ff2_down, g_final=g_final)
    B = x_prompt.shape[0]
    meta = jnp.broadcast_to(meta_tokens.astype(x_prompt.dtype)[None], (B, N_META, D_MODEL))
    xp = jnp.concatenate([meta, x_prompt], axis=1)
    yp, (p_C, p_n, p_m, p_h, p_conv) = trunk(xp, W, None)
    y_prompt = yp[:, N_META:]
    y_sample, (s_C, s_n, s_m, s_h, s_conv) = trunk(
        x_sample, W, (state_mlstm_C, state_mlstm_n, state_mlstm_m, state_lru_h, state_conv))
    return (y_prompt, y_sample, p_C, p_n, p_m, p_h, p_conv, s_C, s_n, s_m, s_h, s_conv)
```

```cpp
#include <hip/hip_runtime.h>
#include <cstdio>
#include <cstdint>
namespace pg8 {
#define PG8_LAS __attribute__((address_space(3)))
typedef unsigned short bf16_t;
typedef short bf16x8 __attribute__((ext_vector_type(8)));
typedef float f32x4 __attribute__((ext_vector_type(4)));
typedef unsigned u32x4 __attribute__((ext_vector_type(4)));
constexpr int BM = 256, BK = 64, HALF = 128, HTB = HALF * BK * 2  , STAGE_BYTES = 8 * HTB, NXCD = 8, WGM = 8;

__host__ __device__ __forceinline__ int lds_byte(int r, int c) { const int st = (r >> 4) * 2 + (c >> 5), rr = r & 15, cc = c & 31, ob = rr * 64 + cc * 2; return st * 1024 + (ob ^ (((ob >> 9) & 1) << 5)); }
__host__ __device__ __forceinline__ void stage_rc(int b, int& R, int& C) { const int st = b / 1024, sb = b % 1024, swz = sb ^ (((sb >> 9) & 1) << 5); R = (st >> 1) * 16 + swz / 64; C = (st & 1) * 32 + (swz % 64) / 2; }
__host__ __device__ __forceinline__ int perm32(int rho) { const int n = rho >> 4, i = rho & 15; return 8 * (i >> 2) + 4 * n + (i & 3); }

struct Unit { int pm, pn; };
struct Gemm { const bf16_t* A; const bf16_t* Bt; int M, N, K; };

struct StaticOrder {
    int nM, nN, nwg, G, c;
    __host__ __device__ void init(int M, int N, int G_, int c_) { nM = M / BM; nN = N / BM; nwg = nM * nN; G = G_; c = c_; }
    __host__ __device__ bool next(int i, Unit& u) const {
        const long L = (long)i * G + c; if (L >= nwg) return false;
        int wgid = (int)L; { const int q = nwg / NXCD, r = nwg % NXCD, xcd = wgid % NXCD, off = wgid / NXCD; wgid = (xcd < r ? xcd * (q + 1) : r * (q + 1) + (xcd - r) * q) + off; }
        const int nig = WGM * nN, gid = wgid / nig, fm = gid * WGM, gsz = (nM - fm) < WGM ? (nM - fm) : WGM;
        u.pm = fm + ((wgid % nig) % gsz); u.pn = (wgid % nig) / gsz; return true;
    }
    __device__ __forceinline__ void a_ready(const Unit&) const {}
    __device__ __forceinline__ void done(const Unit&) const {}
};


__device__ __forceinline__ unsigned cvt_pk_bf16(float lo, float hi) { unsigned r; asm volatile("v_cvt_pk_bf16_f32 %0, %1, %2" : "=v"(r) : "v"(lo), "v"(hi)); return r; }
__device__ __forceinline__ float silu_f(float g) { return g * __builtin_amdgcn_rcpf(1.0f + __expf(-g)); }

constexpr int XSPLIT_TILE = 66;
struct XRows { float* lo; float* tail; __device__ __forceinline__ float* tile(int pm) const { return pm < XSPLIT_TILE ? lo + (size_t)pm * BM * 1024 : tail + (size_t)(pm - XSPLIT_TILE) * BM * 1024; } };

struct EpiSwiGLU {
    static constexpr bool PERM = true, AFTER_DRAIN = false;
    bf16_t* O; int ldc;
    __device__ __forceinline__ void operator()(const f32x4 (&acc)[2][2][4][2], const Unit& u, int wr, int wc, int fr, int fq) const {
        const int row0 = u.pm * BM + wr * 64 + fr; const int col0 = u.pn * HALF + wc * 32 + 8 * fq;
#pragma unroll
        for (int ai = 0; ai < 2; ++ai)
#pragma unroll
            for (int m = 0; m < 4; ++m) { bf16_t* rowp = O + (size_t)(row0 + ai * HALF + m * 16) * ldc + col0;
                const f32x4 g0 = acc[ai][0][m][0], g1 = acc[ai][0][m][1], u0 = acc[ai][1][m][0], u1 = acc[ai][1][m][1];
                u32x4 w;
                w.x = cvt_pk_bf16(silu_f(g0[0]) * u0[0], silu_f(g0[1]) * u0[1]); w.y = cvt_pk_bf16(silu_f(g0[2]) * u0[2], silu_f(g0[3]) * u0[3]);
                w.z = cvt_pk_bf16(silu_f(g1[0]) * u1[0], silu_f(g1[1]) * u1[1]); w.w = cvt_pk_bf16(silu_f(g1[2]) * u1[2], silu_f(g1[3]) * u1[3]);
                *(u32x4*)rowp = w; }
    }
};
struct EpiResid {
    static constexpr bool PERM = false, AFTER_DRAIN = false;
    XRows X; float scale;
    __device__ __forceinline__ void operator()(const f32x4 (&acc)[2][2][4][2], const Unit& u, int wr, int wc, int fr, int fq) const {
        float* base = X.tile(u.pm) + (size_t)(wr * 64 + fr) * 1024 + u.pn * BM + wc * 32 + 4 * fq;
#pragma unroll
        for (int ai = 0; ai < 2; ++ai)
#pragma unroll
            for (int m = 0; m < 4; ++m) { float* rowp = base + (size_t)(ai * HALF + m * 16) * 1024;
#pragma unroll
                for (int bj = 0; bj < 2; ++bj)
#pragma unroll
                    for (int n = 0; n < 2; ++n) { f32x4* p = (f32x4*)(rowp + bj * HALF + n * 16); const f32x4 o = *p + acc[ai][bj][m][n] * scale; *p = o; } }
    }
};
struct EpiZ {
    static constexpr bool PERM = true, AFTER_DRAIN = false;
    bf16_t* Z; float* G;
    __device__ __forceinline__ void operator()(const f32x4 (&acc)[2][2][4][2], const Unit& u, int wr, int wc, int fr, int fq) const {
        const int row0 = u.pm * BM + wr * 64 + fr;
        if (u.pn < 12) {
            const int col0 = u.pn * BM + wc * 32 + 8 * fq;
#pragma unroll
            for (int ai = 0; ai < 2; ++ai)
#pragma unroll
                for (int m = 0; m < 4; ++m) { bf16_t* rowp = Z + (size_t)(row0 + ai * HALF + m * 16) * 3072 + col0;
#pragma unroll
                    for (int bj = 0; bj < 2; ++bj) { const f32x4 v0 = acc[ai][bj][m][0], v1 = acc[ai][bj][m][1];
                        u32x4 w; w.x = cvt_pk_bf16(v0[0], v0[1]); w.y = cvt_pk_bf16(v0[2], v0[3]); w.z = cvt_pk_bf16(v1[0], v1[1]); w.w = cvt_pk_bf16(v1[2], v1[3]);
                        *(u32x4*)(rowp + bj * HALF) = w; } }
        } else if (wc == 0 && fq == 0) {
#pragma unroll
            for (int ai = 0; ai < 2; ++ai)
#pragma unroll
                for (int m = 0; m < 4; ++m) { float* g = G + (size_t)(row0 + ai * HALF + m * 16) * 8;
                    *(f32x4*)g = acc[ai][0][m][0]; *(f32x4*)(g + 4) = acc[ai][0][m][1]; }
        }
    }
};
template <class Epi, class Sched, bool ALIGN_EPI = false, bool SP2 = false>
__device__ __forceinline__ void gemm_phase(PG8_LAS unsigned char* lds, const Gemm g, const Sched& S, const Epi& E, const int tid) {
    const int wid = __builtin_amdgcn_readfirstlane(tid >> 6), lane = tid & 63, wr = wid >> 2, wc = wid & 3, fr = lane & 15, fq = lane >> 4;
    const int K = g.K, nt = K / BK;
    unsigned voffA[2], voffB[2];
#pragma unroll
    for (int i = 0; i < 2; ++i) { int R, C; stage_rc(tid * 16 + i * 8192, R, C); const int Rb = Epi::PERM ? ((R & ~31) + perm32(R & 31)) : R;
        voffA[i] = (unsigned)(R * K + C) * 2u; voffB[i] = (unsigned)(Rb * K + C) * 2u; }
    const size_t kstep = (size_t)(BK * 2);
    const size_t hstep = (size_t)HALF * K * 2;
    const size_t tstep = 2 * hstep;
    const unsigned ldsw = (unsigned)wid * 1024u;
    const int aoff = lds_byte(wr * 64 + fr, fq * 8), boff = lds_byte(wc * 32 + fr, fq * 8);
#define PG8_SA(b, h) (((b) * 2 + (h)) * HTB)
#define PG8_SB(b, h) ((4 + (b) * 2 + (h)) * HTB)
#define PG8_STAGE(bufoff, gbase, voff) do { _Pragma("unroll") for (int _i = 0; _i < 2; ++_i) \
        __builtin_amdgcn_global_load_lds((const unsigned*)((const char*)(gbase) + (voff)[_i]), (PG8_LAS unsigned*)(lds + (bufoff) + ldsw + _i * 8192), 16, 0, 0); } while (0)
#define PG8_LDA(dst, b, h) do { _Pragma("unroll") for (int m = 0; m < 4; ++m) _Pragma("unroll") for (int k = 0; k < 2; ++k) dst[m][k] = *(const PG8_LAS bf16x8*)(lds + PG8_SA(b, h) + aoff + m * 2048 + k * 1024); } while (0)
#define PG8_LDB(dst, b, h) do { _Pragma("unroll") for (int n = 0; n < 2; ++n) _Pragma("unroll") for (int k = 0; k < 2; ++k) dst[n][k] = *(const PG8_LAS bf16x8*)(lds + PG8_SB(b, h) + boff + n * 2048 + k * 1024); } while (0)
#define PG8_MMA(ai, bj, At, Bt) do { __builtin_amdgcn_s_setprio(1); _Pragma("unroll") for (int m = 0; m < 4; ++m) _Pragma("unroll") for (int n = 0; n < 2; ++n) _Pragma("unroll") for (int k = 0; k < 2; ++k) \
        acc[ai][bj][m][n] = __builtin_amdgcn_mfma_f32_16x16x32_bf16(Bt[n][k], At[m][k], acc[ai][bj][m][n], 0, 0, 0); __builtin_amdgcn_s_setprio(0); } while (0)
#define PG8_WAIT_V(n) asm volatile("s_waitcnt vmcnt(" #n ")" ::: "memory")
#define PG8_WAIT_L(n) asm volatile("s_waitcnt lgkmcnt(" #n ")" ::: "memory")
#define PG8_BAR __builtin_amdgcn_s_barrier()
#define PG8_SCHED __builtin_amdgcn_sched_barrier(0)
    Unit cur, nxt; int ui = 0;
    if (!S.next(0, cur)) return;
    f32x4 acc[2][2][4][2];
#pragma unroll
    for (int a = 0; a < 2; ++a)
#pragma unroll
        for (int b = 0; b < 2; ++b)
#pragma unroll
            for (int m = 0; m < 4; ++m)
#pragma unroll
                for (int n = 0; n < 2; ++n) acc[a][b][m][n] = (f32x4){0.f, 0.f, 0.f, 0.f};
    bf16x8 At[4][2], B0[2][2], B1[2][2];
    const char* cA = (const char*)g.A + (size_t)cur.pm * tstep; const char* cB = (const char*)g.Bt + (size_t)cur.pn * tstep;
    S.a_ready(cur);
    if constexpr (SP2) {
        PG8_STAGE(PG8_SB(0, 0), cB, voffB); PG8_STAGE(PG8_SB(0, 1), cB + hstep, voffB); PG8_STAGE(PG8_SA(0, 0), cA, voffA); PG8_STAGE(PG8_SA(0, 1), cA + hstep, voffA);
        if (wr == 1) PG8_BAR;
        PG8_WAIT_V(2); PG8_BAR;
        PG8_STAGE(PG8_SB(1, 0), cB + kstep, voffB); PG8_STAGE(PG8_SA(1, 0), cA + kstep, voffA); PG8_STAGE(PG8_SB(1, 1), cB + hstep + kstep, voffB);
        PG8_WAIT_V(6); PG8_BAR;
    } else {
        PG8_STAGE(PG8_SB(0, 0), cB, voffB); PG8_STAGE(PG8_SA(0, 0), cA, voffA); PG8_STAGE(PG8_SB(0, 1), cB + hstep, voffB); PG8_STAGE(PG8_SA(0, 1), cA + hstep, voffA);
        if (wr == 1) PG8_BAR;
        PG8_WAIT_V(4); PG8_BAR;
        PG8_STAGE(PG8_SB(1, 0), cB + kstep, voffB); PG8_STAGE(PG8_SA(1, 0), cA + kstep, voffA); PG8_STAGE(PG8_SB(1, 1), cB + hstep + kstep, voffB);
        PG8_WAIT_V(6); PG8_BAR;
    }
    for (;;) {
        const bool has_next = S.next(ui + 1, nxt);
        const char* nA = has_next ? (const char*)g.A + (size_t)nxt.pm * tstep : cA; const char* nB = has_next ? (const char*)g.Bt + (size_t)nxt.pn * tstep : cB;
        for (int t = 0; t < nt; t += 2) {
            const bool last = (t == nt - 2);
            const char* a1 = cA + (size_t)(t + 1) * kstep;
            const char* a2 = last ? nA : cA + (size_t)(t + 2) * kstep; const char* b2 = last ? nB : cB + (size_t)(t + 2) * kstep;
            const char* a3 = a2 + kstep; const char* b3 = b2 + kstep;
            if (last && has_next) S.a_ready(nxt);
            if constexpr (SP2) {
            PG8_LDB(B0, 0, 0); PG8_LDB(B1, 0, 1); PG8_SCHED; PG8_LDA(At, 0, 0); PG8_STAGE(PG8_SA(1, 1), a1 + hstep, voffA);
            PG8_WAIT_V(8); PG8_WAIT_L(0); PG8_BAR; PG8_MMA(0, 0, At, B0); PG8_MMA(0, 1, At, B1); PG8_BAR; PG8_SCHED;
            PG8_LDA(At, 0, 1); PG8_STAGE(PG8_SB(0, 0), b2, voffB); PG8_STAGE(PG8_SB(0, 1), b2 + hstep, voffB); PG8_STAGE(PG8_SA(0, 0), a2, voffA);
            PG8_WAIT_V(8); PG8_WAIT_L(0); PG8_BAR; PG8_MMA(1, 0, At, B0); PG8_MMA(1, 1, At, B1); PG8_BAR; PG8_SCHED;
            PG8_LDB(B0, 1, 0); PG8_LDB(B1, 1, 1); PG8_SCHED; PG8_LDA(At, 1, 0); PG8_STAGE(PG8_SA(0, 1), a2 + hstep, voffA);
            PG8_WAIT_V(8); PG8_WAIT_L(0); PG8_BAR; PG8_MMA(0, 0, At, B0); PG8_MMA(0, 1, At, B1); PG8_BAR; PG8_SCHED;
            PG8_LDA(At, 1, 1); PG8_STAGE(PG8_SB(1, 0), b3, voffB); PG8_STAGE(PG8_SB(1, 1), b3 + hstep, voffB); PG8_STAGE(PG8_SA(1, 0), a3, voffA);
            PG8_WAIT_V(8); PG8_WAIT_L(0); PG8_BAR; PG8_MMA(1, 0, At, B0); PG8_MMA(1, 1, At, B1); PG8_BAR; PG8_SCHED;
            } else {
            PG8_LDB(B0, 0, 0); PG8_SCHED; PG8_LDA(At, 0, 0); PG8_STAGE(PG8_SA(1, 1), a1 + hstep, voffA);
            PG8_WAIT_L(8); PG8_BAR; PG8_WAIT_L(0); PG8_MMA(0, 0, At, B0); PG8_BAR; PG8_SCHED;
            PG8_LDB(B1, 0, 1); PG8_STAGE(PG8_SB(0, 0), b2, voffB);
            PG8_BAR; PG8_WAIT_L(0); PG8_MMA(0, 1, At, B1); PG8_BAR;
            PG8_LDA(At, 0, 1); PG8_STAGE(PG8_SA(0, 0), a2, voffA);
            PG8_BAR; PG8_WAIT_L(0); PG8_MMA(1, 0, At, B0); PG8_BAR; PG8_SCHED;
            PG8_STAGE(PG8_SB(0, 1), b2 + hstep, voffB);
            PG8_WAIT_V(6); PG8_BAR; PG8_MMA(1, 1, At, B1); PG8_BAR;
            PG8_LDB(B0, 1, 0); PG8_SCHED; PG8_LDA(At, 1, 0); PG8_STAGE(PG8_SA(0, 1), a2 + hstep, voffA);
            PG8_WAIT_L(8); PG8_BAR; PG8_WAIT_L(0); PG8_MMA(0, 0, At, B0); PG8_BAR; PG8_SCHED;
            PG8_LDB(B1, 1, 1); PG8_STAGE(PG8_SB(1, 0), b3, voffB);
            PG8_BAR; PG8_WAIT_L(0); PG8_MMA(0, 1, At, B1); PG8_BAR;
            PG8_LDA(At, 1, 1); PG8_STAGE(PG8_SA(1, 0), a3, voffA);
            PG8_BAR; PG8_WAIT_L(0); PG8_MMA(1, 0, At, B0); PG8_BAR; PG8_SCHED;
            PG8_STAGE(PG8_SB(1, 1), b3 + hstep, voffB);
            PG8_WAIT_V(6); PG8_BAR; PG8_MMA(1, 1, At, B1); PG8_BAR;
            }
        }
        if constexpr (ALIGN_EPI) { if (wr == 0) PG8_BAR; }
        if constexpr (!Epi::AFTER_DRAIN) { E(acc, cur, wr, wc, fr, fq); S.done(cur); }
        if (!has_next) break;
#pragma unroll
        for (int a = 0; a < 2; ++a)
#pragma unroll
            for (int b = 0; b < 2; ++b)
#pragma unroll
                for (int m = 0; m < 4; ++m)
#pragma unroll
                    for (int n = 0; n < 2; ++n) acc[a][b][m][n] = (f32x4){0.f, 0.f, 0.f, 0.f};
        cur = nxt; cA = nA; cB = nB; ++ui;
        if constexpr (ALIGN_EPI) { if (wr == 1) PG8_BAR; }
    }
    PG8_WAIT_V(0);
    if constexpr (!ALIGN_EPI) { if (wr == 0) PG8_BAR; }
    PG8_BAR;
    if constexpr (Epi::AFTER_DRAIN) { E.fused(acc, cur, wr, wc, fr, fq, lds, wid, lane); S.done(cur); }
#undef PG8_SA
#undef PG8_SB
#undef PG8_STAGE
#undef PG8_LDA
#undef PG8_LDB
#undef PG8_MMA
#undef PG8_WAIT_V
#undef PG8_WAIT_L
#undef PG8_BAR
#undef PG8_SCHED
}
}
#define LAS __attribute__((address_space(3)))
typedef float f32x4 __attribute__((ext_vector_type(4)));
constexpr int XSPLIT_TILE_ROWS = pg8::XSPLIT_TILE * 256;
#define XB_TMO      128
#define XB_XCNT(j)  (256  + 64 * (j))
#define XB_XSUB(j)  (1280 + 64 * (j))
#define XB_XGEN(j)  (2304 + 64 * (j))
#define XB_TOP      3328
#define XB_TOPGEN   3392
#define XCD_BAR_WORDS 3456
#define XB_SPIN_CAP (1u << 18)

__device__ __forceinline__ unsigned xb_ld(unsigned* p)              { return __hip_atomic_load(p, __ATOMIC_RELAXED, __HIP_MEMORY_SCOPE_AGENT); }
__device__ __forceinline__ unsigned xb_add(unsigned* p, unsigned v) { return __hip_atomic_fetch_add(p, v, __ATOMIC_RELAXED, __HIP_MEMORY_SCOPE_AGENT); }
__device__ __forceinline__ unsigned xb_xcc_id() { return (unsigned)__builtin_amdgcn_s_getreg((3 << 11) | 20) & 0xFu; }
#define XB_SPIN(cond, bar) do { unsigned _sp = 0; while (cond) { __builtin_amdgcn_s_sleep(1); \
    if ((++_sp & 255u) == 0u) { if (xb_ld(&(bar)[XB_TMO])) break; if (_sp > XB_SPIN_CAP) { atomicAdd(&(bar)[XB_TMO], 1u); break; } } } } while (0)

struct XcdBarrier {
    unsigned* bar; unsigned x;
    volatile LAS unsigned* st;
};

__device__ __forceinline__ XcdBarrier xcd_barrier_post(unsigned* bar, volatile LAS unsigned* st) {
    XcdBarrier b; b.bar = bar; b.x = xb_xcc_id(); b.st = st;
    if (threadIdx.x == 0) (void)xb_add(&bar[XB_XCNT(b.x)], 1u);
    return b;
}
__device__ __forceinline__ void xcd_barrier_complete(unsigned* bar, unsigned x, unsigned& nloc, unsigned& nx) {
    const unsigned G = gridDim.x * gridDim.y * gridDim.z;
    unsigned sum, cnt, mine, sp = 0u;
    for (;;) {
        sum = 0u; cnt = 0u; mine = 0u;
#pragma unroll
        for (unsigned j = 0; j < 16; ++j) { const unsigned c = xb_ld(&bar[XB_XCNT(j)]); sum += c; cnt += (c > 0u) ? 1u : 0u; mine = (j == x) ? c : mine; }
        if (sum == G) break;
        __builtin_amdgcn_s_sleep(1);
        if ((++sp & 255u) == 0u) { if (xb_ld(&bar[XB_TMO])) break; if (sp > XB_SPIN_CAP) { atomicAdd(&bar[XB_TMO], 1u); break; } }
    }
    nloc = mine > 0u ? mine : 1u; nx = cnt > 0u ? cnt : 1u;
}

__device__ __forceinline__ void xcd_barrier(const XcdBarrier& b) {
    asm volatile("s_waitcnt vmcnt(0)" ::: "memory");
    __syncthreads();
    if (threadIdx.x == 0) {
        unsigned* bar = b.bar;
        __builtin_amdgcn_s_waitcnt(0);
        unsigned nloc = b.st[0], nx = b.st[1];
        if (nloc == 0u) { xcd_barrier_complete(bar, b.x, nloc, nx); b.st[0] = nloc; b.st[1] = nx; }
        const unsigned old = xb_add(&bar[XB_XSUB(b.x)], 1u);
        const unsigned gen = old / nloc;
        if (old + 1u == (gen + 1u) * nloc) {
            __builtin_amdgcn_fence(__ATOMIC_RELEASE, "agent");
            asm volatile("s_waitcnt vmcnt(0)" ::: "memory");
            const unsigned og = xb_add(&bar[XB_TOP], 1u);
            const unsigned tg = og / nx;
            if (og + 1u == (tg + 1u) * nx) xb_add(&bar[XB_TOPGEN], 1u);
            else XB_SPIN(xb_ld(&bar[XB_TOPGEN]) == tg, bar);
            __builtin_amdgcn_fence(__ATOMIC_ACQUIRE, "agent");
            xb_add(&bar[XB_XGEN(b.x)], 1u);
            asm volatile("s_waitcnt vmcnt(0)" ::: "memory");
        } else {
            XB_SPIN(xb_ld(&bar[XB_XGEN(b.x)]) == gen, bar);
            __builtin_amdgcn_fence(__ATOMIC_ACQUIRE, "agent");
            asm volatile("s_waitcnt vmcnt(0)" ::: "memory");
        }
    }
    __syncthreads();
}

constexpr int NWAVES = 8, NTHREADS = 512;
#ifndef MK_ONE_LAUNCH
#define MK_ONE_LAUNCH 1
#endif
constexpr int D = 1024, DFF = 2816, NBATCH = 8, SEQ = 2048, DEC_B = 128, DEC_T = 4, NMETA = 16, NH = 4, DH = 128, DLRU = 512;
constexpr int R_SAMPLE = 16384, R_META = 16896, N_REAL = 16912, MP = 17152;
constexpr int NZ = 3072, NWIN = 3328, NUP = 5632;
constexpr float EPS = 1e-6f;
constexpr size_t O_YP = 0, O_YS = 16777216, O_PC = O_YS + 524288, O_PN = O_PC + 1048576, O_PM = O_PN + 8192, O_PH = O_PM + 64, O_PCONV = O_PH + 8192,
                 O_SC = O_PCONV + 24576, O_SN = O_SC + 16777216, O_SM = O_SN + 131072, O_SH = O_SM + 1024, O_SCONV = O_SH + 131072, O_END = O_SCONV + 393216;
constexpr size_t MiB = 1u << 20;
constexpr size_t WS_CTL = 0, CTL_ZERO_BYTES = 1 * MiB, WS_XTAIL = 1 * MiB, WS_G = 2 * MiB, WS_WB = 3 * MiB;
constexpr size_t LW_U1 = 0, LW_D1 = 11534336, LW_IN = 17301504, LW_O = 24117248, LW_U2 = 26214400, LW_D2 = 37748736, LW_SIZE = 43515904;
constexpr size_t WS_XN = 87 * MiB, WS_MIX = 121 * MiB, WS_HZ = 155 * MiB, WS_END = 256 * MiB;
static_assert(WS_WB + 2 * LW_SIZE <= WS_XN && WS_XN + (size_t)MP * D * 2 <= WS_MIX && WS_MIX + (size_t)MP * D * 2 <= WS_HZ && WS_HZ + (size_t)MP * NZ * 2 <= WS_END && (size_t)MP * DFF * 2 <= (size_t)MP * NZ * 2, "d_ws map");
constexpr int CW_BAR = 4096;
constexpr int RING_BYTES = 131072, LDSCTL_OFF = RING_BYTES, MISC_OFF = LDSCTL_OFF + 320, LDS_BYTES = 147456;

typedef unsigned short bf16;
typedef unsigned v4u __attribute__((ext_vector_type(4)));
typedef unsigned v2u __attribute__((ext_vector_type(2)));
#define LDS_WAIT() asm volatile("s_waitcnt lgkmcnt(0)" ::: "memory")
__device__ __forceinline__ unsigned f2bf(float f) { unsigned u = __builtin_bit_cast(unsigned, f); return (u + 0x7fffu + ((u >> 16) & 1u)) >> 16; }
__device__ __forceinline__ unsigned pk2(float lo, float hi) { return f2bf(lo) | (f2bf(hi) << 16); }
__device__ __forceinline__ float bf2f(bf16 v) { return __builtin_bit_cast(float, (unsigned)v << 16); }
__device__ __forceinline__ float wave_sum(float v) {
#pragma unroll
    for (int o = 1; o < 64; o <<= 1) v += __shfl_xor(v, o);
    return v;
}
__device__ __forceinline__ float sigmoid_f(float x) { return 1.0f / (1.0f + expf(-x)); }
__device__ __forceinline__ float softplus_f(float x) { return fmaxf(x, 0.f) + log1pf(expf(-fabsf(x))); }
__device__ __forceinline__ float gelu_tanh_f(float x) { const float u = 0.7978845608028654f * (x + 0.044715f * x * x * x); return 0.5f * x * (1.0f + tanhf(u)); }

struct Args { const float* in[30]; float* out; unsigned char* ws; int ph_lo, ph_hi, li, pad; };
struct Ctx { volatile LAS unsigned* tab; float* out; unsigned char* ws; };
__device__ __forceinline__ const float* inp(const Ctx& a, int i) { const unsigned lo = __builtin_amdgcn_readfirstlane(a.tab[2 * i]), hi = __builtin_amdgcn_readfirstlane(a.tab[2 * i + 1]); return (const float*)(((unsigned long long)hi << 32) | lo); }
enum { I_XP = 0, I_XS, I_SC, I_SN, I_SM, I_SH, I_SCONV, I_META, I_GFF1, I_W1G, I_W1U, I_W1D, I_GMIX, I_WIN, I_BG, I_CW, I_CB, I_WRA, I_BRA, I_WRX, I_BRX, I_LAM, I_GMO, I_GLO, I_WOUT, I_GFF2, I_W2G, I_W2U, I_W2D, I_GFIN };

__device__ __forceinline__ float* xrow_ptr(const Ctx& a, int r) { return r < XSPLIT_TILE_ROWS ? a.out + (size_t)r * D : (float*)(a.ws + WS_XTAIL) + (size_t)(r - XSPLIT_TILE_ROWS) * D; }

__device__ __forceinline__ void conv_item(const float* W, int K, int Nsrc, int sc0, int nvalid, const float* gamma, float rs, bf16* WT, int n0, int k0, LAS float* scr, int lane) {
#pragma unroll 8
    for (int i = 0; i < 32; ++i) { const int kk = 2 * i + (lane >> 5), j = lane & 31; float v = 0.f;
        if (j < nvalid) { v = W[(size_t)(k0 + kk) * Nsrc + sc0 + j] * rs; if (gamma) v *= gamma[k0 + kk]; }
        scr[kk * 33 + j] = v; }
    LDS_WAIT(); asm volatile("" ::: "memory");
    const int c = lane & 7;
#pragma unroll
    for (int j = 0; j < 4; ++j) { const int n = (lane >> 3) + 8 * j; const LAS float* s = scr + (8 * c) * 33 + n;
        v4u o; o.x = pk2(s[0 * 33], s[1 * 33]); o.y = pk2(s[2 * 33], s[3 * 33]); o.z = pk2(s[4 * 33], s[5 * 33]); o.w = pk2(s[6 * 33], s[7 * 33]);
        *(v4u*)(WT + (size_t)(n0 + n) * K + k0 + 8 * c) = o; }
    LDS_WAIT(); asm volatile("" ::: "memory");
}
constexpr int IT_U = 16 * 176, IT_D = 44 * 32, IT_IN = 16 * 104, IT_O = 16 * 32, IT_LAYER = 2 * IT_U + 2 * IT_D + IT_IN + IT_O;
__device__ __forceinline__ void conv_dispatch(const Ctx& a, int it, LAS float* scr, int lane) {
    const int l = it / IT_LAYER; int r = it % IT_LAYER;
    unsigned char* wb = a.ws + WS_WB + (size_t)l * LW_SIZE;
    if (r < 2 * IT_U) {
        const int second = r >= IT_U; if (second) r -= IT_U;
        const int nb = r % 176, kb = r / 176, n0 = nb * 32, grp = n0 >> 8, w = n0 & 255;
        const float* src = inp(a, second ? (w < 128 ? I_W2G : I_W2U) : (w < 128 ? I_W1G : I_W1U)) + (size_t)l * D * DFF;
        conv_item(src, D, DFF, grp * 128 + (w & 127), 32, inp(a, second ? I_GFF2 : I_GFF1) + l * D, 1.f, (bf16*)(wb + (second ? LW_U2 : LW_U1)), n0, kb * 64, scr, lane);
        return; }
    r -= 2 * IT_U;
    if (r < 2 * IT_D) {
        const int second = r >= IT_D; if (second) r -= IT_D;
        const int nb = r % 32, kb = r / 32;
        conv_item(inp(a, second ? I_W2D : I_W1D) + (size_t)l * DFF * D, DFF, D, nb * 32, 32, nullptr, 1.f, (bf16*)(wb + (second ? LW_D2 : LW_D1)), nb * 32, kb * 64, scr, lane);
        return; }
    r -= 2 * IT_D;
    if (r < IT_IN) {
        const int nb = r % 104, kb = r / 104, n0 = nb * 32; int sc0, nvalid = 32; float rs = 1.f;
        if (n0 < 2048) { sc0 = n0; if (n0 >= 512 && n0 < 1024) rs = 0.08838834764831845f; }
        else if (n0 < 3072) sc0 = n0 + 8;
        else if (n0 == 3072) { sc0 = 2048; nvalid = 8; }
        else { sc0 = 0; nvalid = 0; }
        conv_item(inp(a, I_WIN) + (size_t)l * D * 3080, D, 3080, sc0, nvalid, inp(a, I_GMIX) + l * D, rs, (bf16*)(wb + LW_IN), n0, kb * 64, scr, lane);
        return; }
    r -= IT_IN;
    { const int nb = r % 32, kb = r / 32;
      conv_item(inp(a, I_WOUT) + (size_t)l * D * D, D, D, nb * 32, 32, nullptr, 1.f, (bf16*)(wb + LW_O), nb * 32, kb * 64, scr, lane); }
}
__device__ __forceinline__ void norm_row_to_bf16(const float* xrow, bf16* orow, int lane) {
    const f32x4* xr = (const f32x4*)xrow + lane; f32x4 v[4]; float s = 0.f;
#pragma unroll
    for (int j = 0; j < 4; ++j) { v[j] = xr[64 * j]; s += (v[j].x * v[j].x + v[j].y * v[j].y) + (v[j].z * v[j].z + v[j].w * v[j].w); }
    const float rstd = 1.f / sqrtf(wave_sum(s) * (1.f / D) + EPS);
    unsigned long long* o8 = (unsigned long long*)orow + lane;
#pragma unroll
    for (int j = 0; j < 4; ++j) o8[64 * j] = (unsigned long long)pk2(v[j].x * rstd, v[j].y * rstd) | ((unsigned long long)pk2(v[j].z * rstd, v[j].w * rstd) << 32);
}

__device__ __forceinline__ void mlstm_naive_item(const Ctx& a, int l, int item, LAS float* sm, int tid) {
    const int lane = tid & 63, wave = tid >> 6, e = tid >> 2, qd = tid & 3, d0 = 32 * qd;
    const bool prompt = item < 32; const int b = prompt ? item >> 2 : (item - 32) >> 2, h = prompt ? item & 3 : (item - 32) & 3;
    const bf16* Z = (const bf16*)(a.ws + WS_HZ); const float* G = (const float*)(a.ws + WS_G); bf16* MIX = (bf16*)(a.ws + WS_MIX);
    LAS float* qs = sm; LAS float* ks = sm + 128; LAS float* red = sm + 256; LAS float* red2 = sm + 264;
    float C[32]; float nreg = 0.f, m = 0.f;
#pragma unroll
    for (int j = 0; j < 32; ++j) C[j] = 0.f;
    if (!prompt) {
        const float* C0 = inp(a, I_SC) + ((size_t)(l * DEC_B + b) * NH + h) * DH * DH + (size_t)e * DH + d0;
#pragma unroll
        for (int j = 0; j < 32; ++j) C[j] = C0[j];
        if (tid < 128) nreg = inp(a, I_SN)[((size_t)(l * DEC_B + b) * NH + h) * DH + tid];
        m = inp(a, I_SM)[(l * DEC_B + b) * NH + h];
    }
    const float big = inp(a, I_BG)[l * 8 + h], bfg = inp(a, I_BG)[l * 8 + 4 + h];
    const float gm = inp(a, I_GMO)[l * 512 + h * DH + e];
    const int nsteps = prompt ? NMETA + SEQ : DEC_T;
    for (int t = 0; t < nsteps; ++t) {
        const int row = prompt ? (t < NMETA ? R_META + t : b * SEQ + (t - NMETA)) : R_SAMPLE + b * DEC_T + t;
        const bf16* zr = Z + (size_t)row * NZ;
        if (tid < 128) { qs[tid] = bf2f(zr[h * DH + tid]); ks[tid] = bf2f(zr[512 + h * DH + tid]); }
        const float ve = bf2f(zr[1024 + h * DH + e]), oe = bf2f(zr[1536 + h * DH + e]);
        const float ig = G[(size_t)row * 8 + h] + big, fg = G[(size_t)row * 8 + 4 + h] + bfg;
        const float logf = -softplus_f(-fg);
        const float mn = fmaxf(logf + m, ig), decay = expf(logf + m - mn), igw = expf(ig - mn);
        m = mn;
        __syncthreads();
        float num = 0.f; const float iv = igw * ve;
#pragma unroll
        for (int j = 0; j < 32; ++j) { C[j] = decay * C[j] + iv * ks[d0 + j]; num += C[j] * qs[d0 + j]; }
        num += __shfl_xor(num, 1); num += __shfl_xor(num, 2);
        float pd = 0.f;
        if (tid < 128) { nreg = decay * nreg + igw * ks[tid]; pd = nreg * qs[tid]; }
        if (wave < 2) { pd = wave_sum(pd); if (lane == 0) red[wave] = pd; }
        __syncthreads();
        const float den = red[0] + red[1];
        const float hv = num / fmaxf(fabsf(den), expf(-mn));
        float sq = (qd == 0) ? hv * hv : 0.f; sq = wave_sum(sq); if (lane == 0) red2[wave] = sq;
        __syncthreads();
        float ss = 0.f;
#pragma unroll
        for (int w = 0; w < 8; ++w) ss += red2[w];
        if (qd == 0 && (!prompt || t >= NMETA || b == 0)) {
            const float y = hv * (1.0f / sqrtf(ss * (1.f / DH) + EPS)) * gm * sigmoid_f(oe);
            MIX[(size_t)row * D + h * DH + e] = (bf16)f2bf(y);
        }
    }
    float* oC = a.out + (prompt ? O_PC + ((size_t)(l * NBATCH + b) * NH + h) * DH * DH : O_SC + ((size_t)(l * DEC_B + b) * NH + h) * DH * DH) + (size_t)e * DH + d0;
#pragma unroll
    for (int j = 0; j < 32; ++j) oC[j] = C[j];
    if (tid < 128) a.out[(prompt ? O_PN + ((size_t)(l * NBATCH + b) * NH + h) * DH : O_SN + ((size_t)(l * DEC_B + b) * NH + h) * DH) + tid] = nreg;
    if (tid == 0) a.out[prompt ? O_PM + (l * NBATCH + b) * NH + h : O_SM + (l * DEC_B + b) * NH + h] = m;
    __syncthreads();
}
__device__ __forceinline__ void lru_naive_item(const Ctx& a, int l, int item, LAS float* sm, int tid) {
    const int lane = tid & 63, wave = tid >> 6, c = tid;
    const bool prompt = item < 8; const int b = prompt ? item : item - 8;
    const bf16* Z = (const bf16*)(a.ws + WS_HZ); bf16* MIX = (bf16*)(a.ws + WS_MIX);
    LAS float* red = sm + 33024;
    LAS float* wxs = sm + wave * 4096 + lane;
    float wa[64];
    { const float* pa = inp(a, I_WRA) + (size_t)(l * 8 + wave) * 4096 + lane; const float* px = inp(a, I_WRX) + (size_t)(l * 8 + wave) * 4096 + lane;
#pragma unroll
      for (int d = 0; d < 64; ++d) { wa[d] = pa[d * 64]; wxs[d * 64] = px[d * 64]; } }
    const float cw0 = inp(a, I_CW)[(l * 4 + 0) * 512 + c], cw1 = inp(a, I_CW)[(l * 4 + 1) * 512 + c], cw2 = inp(a, I_CW)[(l * 4 + 2) * 512 + c], cw3 = inp(a, I_CW)[(l * 4 + 3) * 512 + c];
    const float cb = inp(a, I_CB)[l * 512 + c], ba = inp(a, I_BRA)[l * 512 + c], bx = inp(a, I_BRX)[l * 512 + c];
    const float sp = 8.0f * softplus_f(-inp(a, I_LAM)[l * 512 + c]), gl = inp(a, I_GLO)[l * 512 + c];
    float x3 = 0.f, x2 = 0.f, x1 = 0.f, hst = 0.f;
    if (!prompt) { const float* cs = inp(a, I_SCONV) + (size_t)(l * DEC_B + b) * 3 * 512; x3 = cs[c]; x2 = cs[512 + c]; x1 = cs[1024 + c]; hst = inp(a, I_SH)[(size_t)(l * DEC_B + b) * 512 + c]; }
    const int nsteps = prompt ? NMETA + SEQ : DEC_T;
    for (int t = 0; t < nsteps; ++t) {
        const int row = prompt ? (t < NMETA ? R_META + t : b * SEQ + (t - NMETA)) : R_SAMPLE + b * DEC_T + t;
        const bf16* zr = Z + (size_t)row * NZ;
        const float x0 = bf2f(zr[2048 + c]), yg = bf2f(zr[2560 + c]);
        const float xc = cb + x3 * cw0 + x2 * cw1 + x1 * cw2 + x0 * cw3;
        float ra = ba, ri = bx;
#pragma unroll
        for (int d = 0; d < 64; ++d) { const float xd = __builtin_bit_cast(float, __builtin_amdgcn_readlane(__builtin_bit_cast(int, xc), d)); ra += xd * wa[d]; ri += xd * wxs[d * 64]; }
        const float r = sigmoid_f(ra), ig = sigmoid_f(ri);
        const float log_a = -sp * r, av = expf(log_a), bin = sqrtf(-expm1f(2.0f * log_a)) * (ig * xc);
        hst = av * hst + bin;
        float sq = wave_sum(hst * hst); LAS float* rp = red + (t & 1) * 8; if (lane == 0) rp[wave] = sq;
        __syncthreads();
        float ss = 0.f;
#pragma unroll
        for (int w = 0; w < 8; ++w) ss += rp[w];
        if (!prompt || t >= NMETA || b == 0) {
            const float y = hst * (1.0f / sqrtf(ss * (1.f / 512.f) + EPS)) * gl * gelu_tanh_f(yg);
            MIX[(size_t)row * D + 512 + c] = (bf16)f2bf(y);
        }
        x3 = x2; x2 = x1; x1 = x0;
    }
    if (prompt) { a.out[O_PH + (size_t)(l * NBATCH + b) * 512 + c] = hst; float* pc = a.out + O_PCONV + (size_t)(l * NBATCH + b) * 3 * 512; pc[c] = x3; pc[512 + c] = x2; pc[1024 + c] = x1; }
    else { a.out[O_SH + (size_t)(l * DEC_B + b) * 512 + c] = hst; float* pc = a.out + O_SCONV + (size_t)(l * DEC_B + b) * 3 * 512; pc[c] = x3; pc[512 + c] = x2; pc[1024 + c] = x1; }
    __syncthreads();
}

constexpr int N_PHASES = 23;
constexpr int TAB_OFF = MISC_OFF + 128;
static_assert(TAB_OFF + 256 <= LDS_BYTES, "LDS map");
__global__ void __launch_bounds__(NTHREADS, 2) mega_fwd(Args args) {
    extern __shared__ __attribute__((aligned(16))) unsigned char lds_raw[];
    LAS unsigned char* lds = (LAS unsigned char*)lds_raw;
    volatile LAS unsigned* MISC = (volatile LAS unsigned*)(lds + MISC_OFF);
    const int tid0 = threadIdx.x;
    for (int u = tid0; u < (LDS_BYTES - LDSCTL_OFF) / 4; u += NTHREADS) ((LAS unsigned*)(lds + LDSCTL_OFF))[u] = 0u;
    __syncthreads();
    if (tid0 == 0) {
        volatile LAS unsigned* tab = (volatile LAS unsigned*)(lds + TAB_OFF);
#pragma unroll
        for (int i = 0; i < 30; ++i) { const unsigned long long v = (unsigned long long)args.in[i]; tab[2 * i] = (unsigned)v; tab[2 * i + 1] = (unsigned)(v >> 32); }
    }
    __syncthreads();
    XcdBarrier bar; bar.bar = (unsigned*)(args.ws + WS_CTL) + CW_BAR; bar.x = 0; bar.st = nullptr;
    if ((args.ph_hi - args.ph_lo) > 1) bar = xcd_barrier_post((unsigned*)(args.ws + WS_CTL) + CW_BAR, MISC + 8);

    for (int p = args.ph_lo; p < args.ph_hi; ++p) {
        if (p > args.ph_lo) { XcdBarrier b2 = bar; asm volatile("" : "+s"(b2.bar), "+s"(b2.x)); xcd_barrier(b2); }
        Ctx cx; { unsigned tv = (unsigned)(size_t)(lds + TAB_OFF); asm volatile("" : "+v"(tv)); cx.tab = (volatile LAS unsigned*)(size_t)tv; } cx.out = args.out; cx.ws = args.ws;
        int G = gridDim.x, bx = blockIdx.x, tid = tid0;
        asm volatile("" : "+s"(cx.out), "+s"(cx.ws), "+s"(G), "+s"(bx), "+v"(tid));
        unsigned char* ws = cx.ws;
        const int lane = tid & 63, wave = __builtin_amdgcn_readfirstlane(tid >> 6);
        const int vcu = (G % 8 == 0) ? (bx % 8) * (G / 8) + bx / 8 : bx;
        const int gw = vcu * NWAVES + wave, NGW = G * NWAVES;
        bf16* XN = (bf16*)(ws + WS_XN); bf16* MIX = (bf16*)(ws + WS_MIX); bf16* HZ = (bf16*)(ws + WS_HZ); float* GATES = (float*)(ws + WS_G);
        const pg8::XRows XR{cx.out, (float*)(ws + WS_XTAIL)};
        if (p == 0) {
            LAS float* scr = (LAS float*)(lds + wave * 16384);
            for (int it = gw; it < 2 * IT_LAYER; it += NGW) conv_dispatch(cx, it, scr, lane);
            for (int r = gw; r < MP; r += NGW) {
                float* xo = xrow_ptr(cx, r);
                if (r < N_REAL) {
                    const float* src = r < R_SAMPLE ? inp(cx, I_XP) + (size_t)r * D : (r < R_META ? inp(cx, I_XS) + (size_t)(r - R_SAMPLE) * D : inp(cx, I_META) + (size_t)(r - R_META) * D);
#pragma unroll
                    for (int j = 0; j < 4; ++j) ((f32x4*)xo)[lane + 64 * j] = ((const f32x4*)src)[lane + 64 * j];
                    norm_row_to_bf16(src, XN + (size_t)r * D, lane);
                } else {
#pragma unroll
                    for (int j = 0; j < 4; ++j) ((f32x4*)xo)[lane + 64 * j] = (f32x4){0.f, 0.f, 0.f, 0.f};
                    for (int j = 0; j < 2; ++j) { ((v4u*)(XN + (size_t)r * D))[lane + 64 * j] = (v4u){0u, 0u, 0u, 0u}; ((v4u*)(MIX + (size_t)r * D))[lane + 64 * j] = (v4u){0u, 0u, 0u, 0u}; }
                }
            }
            continue;
        }
        const int l = (p - 1) / 11, k = (p - 1) % 11;
        const unsigned char* wb = ws + WS_WB + (size_t)l * LW_SIZE;
        if (k == 0 || k == 8) {
            pg8::Gemm g{XN, (const bf16*)(wb + (k == 0 ? LW_U1 : LW_U2)), MP, NUP, D}; pg8::StaticOrder S; S.init(MP, NUP, G, bx);
            pg8::EpiSwiGLU E{HZ, DFF};
            pg8::gemm_phase<pg8::EpiSwiGLU, pg8::StaticOrder, true, true>(lds, g, S, E, tid);
        } else if (k == 1 || k == 9) {
            pg8::Gemm g{HZ, (const bf16*)(wb + (k == 1 ? LW_D1 : LW_D2)), MP, D, DFF}; pg8::StaticOrder S; S.init(MP, D, G, bx);
            pg8::EpiResid E{XR, 0.5f};
            pg8::gemm_phase<pg8::EpiResid, pg8::StaticOrder, true, true>(lds, g, S, E, tid);
        } else if (k == 6) {
            pg8::Gemm g{MIX, (const bf16*)(wb + LW_O), MP, D, D}; pg8::StaticOrder S; S.init(MP, D, G, bx);
            pg8::EpiResid E{XR, 1.0f};
            pg8::gemm_phase<pg8::EpiResid, pg8::StaticOrder, true, true>(lds, g, S, E, tid);
        } else if (k == 3) {
            pg8::Gemm g{XN, (const bf16*)(wb + LW_IN), MP, NWIN, D}; pg8::StaticOrder S; S.init(MP, NWIN, G, bx);
            pg8::EpiZ E{HZ, GATES};
            pg8::gemm_phase<pg8::EpiZ, pg8::StaticOrder, true, true>(lds, g, S, E, tid);
        } else if (k == 2 || k == 7 || (k == 10 && l == 0)) {
            for (int r = gw; r < MP; r += NGW) norm_row_to_bf16(xrow_ptr(cx, r), XN + (size_t)r * D, lane);
        } else if (k == 10) {
            const float* gfin = inp(cx, I_GFIN);
            for (int r = gw; r < R_META; r += NGW) {
                f32x4* xr = (f32x4*)xrow_ptr(cx, r) + lane; const f32x4* gf = (const f32x4*)gfin + lane; f32x4 v[4]; float s = 0.f;
#pragma unroll
                for (int j = 0; j < 4; ++j) { v[j] = xr[64 * j]; s += (v[j].x * v[j].x + v[j].y * v[j].y) + (v[j].z * v[j].z + v[j].w * v[j].w); }
                const float rstd = 1.f / sqrtf(wave_sum(s) * (1.f / D) + EPS);
#pragma unroll
                for (int j = 0; j < 4; ++j) xr[64 * j] = v[j] * rstd * gf[64 * j];
            }
        } else if (k == 4) {
            for (int it = vcu; it < 32 + DEC_B * NH; it += G) mlstm_naive_item(cx, l, it, (LAS float*)lds, tid);
        } else if (k == 5) {
            for (int it = vcu; it < 8 + DEC_B; it += G) lru_naive_item(cx, l, it, (LAS float*)lds, tid);
        }
    }
}

extern "C" void kernel_launch(void* const* d_in, const int* in_sizes, int n_in, void* d_out, int out_size, void* d_ws, size_t ws_size, hipStream_t stream) {
    static int grid = 0;
    if (grid == 0) {
        if (n_in != 30 || out_size != (int)O_END || ws_size < WS_END) { fprintf(stderr, "kernel_launch: unexpected shapes: n_in %d out %d ws %zu\n", n_in, out_size, ws_size); grid = -1; return; }
        int dev = 0, cus = 0, per_cu = 0;
        if (hipGetDevice(&dev) != hipSuccess || hipDeviceGetAttribute(&cus, hipDeviceAttributeMultiprocessorCount, dev) != hipSuccess) { grid = -1; return; }
        if (hipFuncSetAttribute((const void*)mega_fwd, hipFuncAttributeMaxDynamicSharedMemorySize, LDS_BYTES) != hipSuccess) { fprintf(stderr, "kernel_launch: hipFuncSetAttribute failed\n"); grid = -1; return; }
        if (hipOccupancyMaxActiveBlocksPerMultiprocessor(&per_cu, (const void*)mega_fwd, NTHREADS, LDS_BYTES) != hipSuccess || per_cu < 1)
            fprintf(stderr, "kernel_launch: note: occupancy query reports %d workgroups per CU\n", per_cu);
        (void)hipGetLastError();
        grid = cus;
    }
    if (grid < 0) return;
    if (hipMemsetAsync((char*)d_ws + WS_CTL, 0, CTL_ZERO_BYTES, stream) != hipSuccess) { fprintf(stderr, "kernel_launch: hipMemsetAsync failed\n"); return; }
    Args a{};
    for (int i = 0; i < 30; ++i) a.in[i] = (const float*)d_in[i];
    a.out = (float*)d_out; a.ws = (unsigned char*)d_ws;
#if MK_ONE_LAUNCH
    a.ph_lo = 0; a.ph_hi = N_PHASES; a.li = 0;
    hipLaunchKernelGGL(mega_fwd, dim3(grid), dim3(NTHREADS), LDS_BYTES, stream, a);
#else
    for (int p = 0; p < N_PHASES; ++p) { a.ph_lo = p; a.ph_hi = p + 1; a.li = p; hipLaunchKernelGGL(mega_fwd, dim3(grid), dim3(NTHREADS), LDS_BYTES, stream, a); }
#endif
}
```

```cpp
#include <hip/hip_runtime.h>
#include <cstdio>
#include <cstdint>
namespace pg8 {
#define PG8_LAS __attribute__((address_space(3)))
typedef unsigned short bf16_t;
typedef short bf16x8 __attribute__((ext_vector_type(8)));
typedef float f32x4 __attribute__((ext_vector_type(4)));
typedef unsigned u32x4 __attribute__((ext_vector_type(4)));
constexpr int BM = 256, BK = 64, HALF = 128, HTB = HALF * BK * 2  , STAGE_BYTES = 8 * HTB, NXCD = 8, WGM = 8;

__host__ __device__ __forceinline__ int lds_byte(int r, int c) { const int st = (r >> 4) * 2 + (c >> 5), rr = r & 15, cc = c & 31, ob = rr * 64 + cc * 2; return st * 1024 + (ob ^ (((ob >> 9) & 1) << 5)); }
__host__ __device__ __forceinline__ void stage_rc(int b, int& R, int& C) { const int st = b / 1024, sb = b % 1024, swz = sb ^ (((sb >> 9) & 1) << 5); R = (st >> 1) * 16 + swz / 64; C = (st & 1) * 32 + (swz % 64) / 2; }
__host__ __device__ __forceinline__ int perm32(int rho) { const int n = rho >> 4, i = rho & 15; return 8 * (i >> 2) + 4 * n + (i & 3); }

struct Unit { int pm, pn; };
struct Gemm { const bf16_t* A; const bf16_t* Bt; int M, N, K; };

struct StaticOrder {
    int nM, nN, nwg, G, c;
    __host__ __device__ void init(int M, int N, int G_, int c_) { nM = M / BM; nN = N / BM; nwg = nM * nN; G = G_; c = c_; }
    __host__ __device__ bool next(int i, Unit& u) const {
        const long L = (long)i * G + c; if (L >= nwg) return false;
        int wgid = (int)L; { const int q = nwg / NXCD, r = nwg % NXCD, xcd = wgid % NXCD, off = wgid / NXCD; wgid = (xcd < r ? xcd * (q + 1) : r * (q + 1) + (xcd - r) * q) + off; }
        const int nig = WGM * nN, gid = wgid / nig, fm = gid * WGM, gsz = (nM - fm) < WGM ? (nM - fm) : WGM;
        u.pm = fm + ((wgid % nig) % gsz); u.pn = (wgid % nig) / gsz; return true;
    }
    __device__ __forceinline__ void a_ready(const Unit&) const {}
    __device__ __forceinline__ void done(const Unit&) const {}
};


__device__ __forceinline__ unsigned cvt_pk_bf16(float lo, float hi) { unsigned r; asm volatile("v_cvt_pk_bf16_f32 %0, %1, %2" : "=v"(r) : "v"(lo), "v"(hi)); return r; }
__device__ __forceinline__ float silu_f(float g) { return g * __builtin_amdgcn_rcpf(1.0f + __expf(-g)); }

constexpr int XSPLIT_TILE = 66;
struct XRows { float* lo; float* tail; __device__ __forceinline__ float* tile(int pm) const { return pm < XSPLIT_TILE ? lo + (size_t)pm * BM * 1024 : tail + (size_t)(pm - XSPLIT_TILE) * BM * 1024; } };

struct EpiSwiGLU {
    static constexpr bool PERM = true, AFTER_DRAIN = false;
    bf16_t* O; int ldc;
    __device__ __forceinline__ void operator()(const f32x4 (&acc)[2][2][4][2], const Unit& u, int wr, int wc, int fr, int fq) const {
        const int row0 = u.pm * BM + wr * 64 + fr; const int col0 = u.pn * HALF + wc * 32 + 8 * fq;
#pragma unroll
        for (int ai = 0; ai < 2; ++ai)
#pragma unroll
            for (int m = 0; m < 4; ++m) { bf16_t* rowp = O + (size_t)(row0 + ai * HALF + m * 16) * ldc + col0;
                const f32x4 g0 = acc[ai][0][m][0], g1 = acc[ai][0][m][1], u0 = acc[ai][1][m][0], u1 = acc[ai][1][m][1];
                u32x4 w;
                w.x = cvt_pk_bf16(silu_f(g0[0]) * u0[0], silu_f(g0[1]) * u0[1]); w.y = cvt_pk_bf16(silu_f(g0[2]) * u0[2], silu_f(g0[3]) * u0[3]);
                w.z = cvt_pk_bf16(silu_f(g1[0]) * u1[0], silu_f(g1[1]) * u1[1]); w.w = cvt_pk_bf16(silu_f(g1[2]) * u1[2], silu_f(g1[3]) * u1[3]);
                *(u32x4*)rowp = w; }
    }
};
struct EpiResid {
    static constexpr bool PERM = false, AFTER_DRAIN = false;
    XRows X; float scale;
    __device__ __forceinline__ void operator()(const f32x4 (&acc)[2][2][4][2], const Unit& u, int wr, int wc, int fr, int fq) const {
        float* base = X.tile(u.pm) + (size_t)(wr * 64 + fr) * 1024 + u.pn * BM + wc * 32 + 4 * fq;
#pragma unroll
        for (int ai = 0; ai < 2; ++ai)
#pragma unroll
            for (int m = 0; m < 4; ++m) { float* rowp = base + (size_t)(ai * HALF + m * 16) * 1024;
#pragma unroll
                for (int bj = 0; bj < 2; ++bj)
#pragma unroll
                    for (int n = 0; n < 2; ++n) { f32x4* p = (f32x4*)(rowp + bj * HALF + n * 16); const f32x4 o = *p + acc[ai][bj][m][n] * scale; *p = o; } }
    }
};
struct EpiZ {
    static constexpr bool PERM = true, AFTER_DRAIN = false;
    bf16_t* Z; float* G;
    __device__ __forceinline__ void operator()(const f32x4 (&acc)[2][2][4][2], const Unit& u, int wr, int wc, int fr, int fq) const {
        const int row0 = u.pm * BM + wr * 64 + fr;
        if (u.pn < 12) {
            const int col0 = u.pn * BM + wc * 32 + 8 * fq;
#pragma unroll
            for (int ai = 0; ai < 2; ++ai)
#pragma unroll
                for (int m = 0; m < 4; ++m) { bf16_t* rowp = Z + (size_t)(row0 + ai * HALF + m * 16) * 3072 + col0;
#pragma unroll
                    for (int bj = 0; bj < 2; ++bj) { const f32x4 v0 = acc[ai][bj][m][0], v1 = acc[ai][bj][m][1];
                        u32x4 w; w.x = cvt_pk_bf16(v0[0], v0[1]); w.y = cvt_pk_bf16(v0[2], v0[3]); w.z = cvt_pk_bf16(v1[0], v1[1]); w.w = cvt_pk_bf16(v1[2], v1[3]);
                        *(u32x4*)(rowp + bj * HALF) = w; } }
        } else if (wc == 0 && fq == 0) {
#pragma unroll
            for (int ai = 0; ai < 2; ++ai)
#pragma unroll
                for (int m = 0; m < 4; ++m) { float* g = G + (size_t)(row0 + ai * HALF + m * 16) * 8;
                    *(f32x4*)g = acc[ai][0][m][0]; *(f32x4*)(g + 4) = acc[ai][0][m][1]; }
        }
    }
};
template <class Epi, class Sched, bool ALIGN_EPI = false, bool SP2 = false>
__device__ __forceinline__ void gemm_phase(PG8_LAS unsigned char* lds, const Gemm g, const Sched& S, const Epi& E, const int tid) {
    const int wid = __builtin_amdgcn_readfirstlane(tid >> 6), lane = tid & 63, wr = wid >> 2, wc = wid & 3, fr = lane & 15, fq = lane >> 4;
    const int K = g.K, nt = K / BK;
    unsigned voffA[2], voffB[2];
#pragma unroll
    for (int i = 0; i < 2; ++i) { int R, C; stage_rc(tid * 16 + i * 8192, R, C); const int Rb = Epi::PERM ? ((R & ~31) + perm32(R & 31)) : R;
        voffA[i] = (unsigned)(R * K + C) * 2u; voffB[i] = (unsigned)(Rb * K + C) * 2u; }
    const size_t kstep = (size_t)(BK * 2);
    const size_t hstep = (size_t)HALF * K * 2;
    const size_t tstep = 2 * hstep;
    const unsigned ldsw = (unsigned)wid * 1024u;
    const int aoff = lds_byte(wr * 64 + fr, fq * 8), boff = lds_byte(wc * 32 + fr, fq * 8);
#define PG8_SA(b, h) (((b) * 2 + (h)) * HTB)
#define PG8_SB(b, h) ((4 + (b) * 2 + (h)) * HTB)
#define PG8_STAGE(bufoff, gbase, voff) do { _Pragma("unroll") for (int _i = 0; _i < 2; ++_i) \
        __builtin_amdgcn_global_load_lds((const unsigned*)((const char*)(gbase) + (voff)[_i]), (PG8_LAS unsigned*)(lds + (bufoff) + ldsw + _i * 8192), 16, 0, 0); } while (0)
#define PG8_LDA(dst, b, h) do { _Pragma("unroll") for (int m = 0; m < 4; ++m) _Pragma("unroll") for (int k = 0; k < 2; ++k) dst[m][k] = *(const PG8_LAS bf16x8*)(lds + PG8_SA(b, h) + aoff + m * 2048 + k * 1024); } while (0)
#define PG8_LDB(dst, b, h) do { _Pragma("unroll") for (int n = 0; n < 2; ++n) _Pragma("unroll") for (int k = 0; k < 2; ++k) dst[n][k] = *(const PG8_LAS bf16x8*)(lds + PG8_SB(b, h) + boff + n * 2048 + k * 1024); } while (0)
#define PG8_MMA(ai, bj, At, Bt) do { __builtin_amdgcn_s_setprio(1); _Pragma("unroll") for (int m = 0; m < 4; ++m) _Pragma("unroll") for (int n = 0; n < 2; ++n) _Pragma("unroll") for (int k = 0; k < 2; ++k) \
        acc[ai][bj][m][n] = __builtin_amdgcn_mfma_f32_16x16x32_bf16(Bt[n][k], At[m][k], acc[ai][bj][m][n], 0, 0, 0); __builtin_amdgcn_s_setprio(0); } while (0)
#define PG8_WAIT_V(n) asm volatile("s_waitcnt vmcnt(" #n ")" ::: "memory")
#define PG8_WAIT_L(n) asm volatile("s_waitcnt lgkmcnt(" #n ")" ::: "memory")
#define PG8_BAR __builtin_amdgcn_s_barrier()
#define PG8_SCHED __builtin_amdgcn_sched_barrier(0)
    Unit cur, nxt; int ui = 0;
    if (!S.next(0, cur)) return;
    f32x4 acc[2][2][4][2];
#pragma unroll
    for (int a = 0; a < 2; ++a)
#pragma unroll
        for (int b = 0; b < 2; ++b)
#pragma unroll
            for (int m = 0; m < 4; ++m)
#pragma unroll
                for (int n = 0; n < 2; ++n) acc[a][b][m][n] = (f32x4){0.f, 0.f, 0.f, 0.f};
    bf16x8 At[4][2], B0[2][2], B1[2][2];
    const char* cA = (const char*)g.A + (size_t)cur.pm * tstep; const char* cB = (const char*)g.Bt + (size_t)cur.pn * tstep;
    S.a_ready(cur);
    if constexpr (SP2) {
        PG8_STAGE(PG8_SB(0, 0), cB, voffB); PG8_STAGE(PG8_SB(0, 1), cB + hstep, voffB); PG8_STAGE(PG8_SA(0, 0), cA, voffA); PG8_STAGE(PG8_SA(0, 1), cA + hstep, voffA);
        if (wr == 1) PG8_BAR;
        PG8_WAIT_V(2); PG8_BAR;
        PG8_STAGE(PG8_SB(1, 0), cB + kstep, voffB); PG8_STAGE(PG8_SA(1, 0), cA + kstep, voffA); PG8_STAGE(PG8_SB(1, 1), cB + hstep + kstep, voffB);
        PG8_WAIT_V(6); PG8_BAR;
    } else {
        PG8_STAGE(PG8_SB(0, 0), cB, voffB); PG8_STAGE(PG8_SA(0, 0), cA, voffA); PG8_STAGE(PG8_SB(0, 1), cB + hstep, voffB); PG8_STAGE(PG8_SA(0, 1), cA + hstep, voffA);
        if (wr == 1) PG8_BAR;
        PG8_WAIT_V(4); PG8_BAR;
        PG8_STAGE(PG8_SB(1, 0), cB + kstep, voffB); PG8_STAGE(PG8_SA(1, 0), cA + kstep, voffA); PG8_STAGE(PG8_SB(1, 1), cB + hstep + kstep, voffB);
        PG8_WAIT_V(6); PG8_BAR;
    }
    for (;;) {
        const bool has_next = S.next(ui + 1, nxt);
        const char* nA = has_next ? (const char*)g.A + (size_t)nxt.pm * tstep : cA; const char* nB = has_next ? (const char*)g.Bt + (size_t)nxt.pn * tstep : cB;
        for (int t = 0; t < nt; t += 2) {
            const bool last = (t == nt - 2);
            const char* a1 = cA + (size_t)(t + 1) * kstep;
            const char* a2 = last ? nA : cA + (size_t)(t + 2) * kstep; const char* b2 = last ? nB : cB + (size_t)(t + 2) * kstep;
            const char* a3 = a2 + kstep; const char* b3 = b2 + kstep;
            if (last && has_next) S.a_ready(nxt);
            if constexpr (SP2) {
            PG8_LDB(B0, 0, 0); PG8_LDB(B1, 0, 1); PG8_SCHED; PG8_LDA(At, 0, 0); PG8_STAGE(PG8_SA(1, 1), a1 + hstep, voffA);
            PG8_WAIT_V(8); PG8_WAIT_L(0); PG8_BAR; PG8_MMA(0, 0, At, B0); PG8_MMA(0, 1, At, B1); PG8_BAR; PG8_SCHED;
            PG8_LDA(At, 0, 1); PG8_STAGE(PG8_SB(0, 0), b2, voffB); PG8_STAGE(PG8_SB(0, 1), b2 + hstep, voffB); PG8_STAGE(PG8_SA(0, 0), a2, voffA);
            PG8_WAIT_V(8); PG8_WAIT_L(0); PG8_BAR; PG8_MMA(1, 0, At, B0); PG8_MMA(1, 1, At, B1); PG8_BAR; PG8_SCHED;
            PG8_LDB(B0, 1, 0); PG8_LDB(B1, 1, 1); PG8_SCHED; PG8_LDA(At, 1, 0); PG8_STAGE(PG8_SA(0, 1), a2 + hstep, voffA);
            PG8_WAIT_V(8); PG8_WAIT_L(0); PG8_BAR; PG8_MMA(0, 0, At, B0); PG8_MMA(0, 1, At, B1); PG8_BAR; PG8_SCHED;
            PG8_LDA(At, 1, 1); PG8_STAGE(PG8_SB(1, 0), b3, voffB); PG8_STAGE(PG8_SB(1, 1), b3 + hstep, voffB); PG8_STAGE(PG8_SA(1, 0), a3, voffA);
            PG8_WAIT_V(8); PG8_WAIT_L(0); PG8_BAR; PG8_MMA(1, 0, At, B0); PG8_MMA(1, 1, At, B1); PG8_BAR; PG8_SCHED;
            } else {
            PG8_LDB(B0, 0, 0); PG8_SCHED; PG8_LDA(At, 0, 0); PG8_STAGE(PG8_SA(1, 1), a1 + hstep, voffA);
            PG8_WAIT_L(8); PG8_BAR; PG8_WAIT_L(0); PG8_MMA(0, 0, At, B0); PG8_BAR; PG8_SCHED;
            PG8_LDB(B1, 0, 1); PG8_STAGE(PG8_SB(0, 0), b2, voffB);
            PG8_BAR; PG8_WAIT_L(0); PG8_MMA(0, 1, At, B1); PG8_BAR;
            PG8_LDA(At, 0, 1); PG8_STAGE(PG8_SA(0, 0), a2, voffA);
            PG8_BAR; PG8_WAIT_L(0); PG8_MMA(1, 0, At, B0); PG8_BAR; PG8_SCHED;
            PG8_STAGE(PG8_SB(0, 1), b2 + hstep, voffB);
            PG8_WAIT_V(6); PG8_BAR; PG8_MMA(1, 1, At, B1); PG8_BAR;
            PG8_LDB(B0, 1, 0); PG8_SCHED; PG8_LDA(At, 1, 0); PG8_STAGE(PG8_SA(0, 1), a2 + hstep, voffA);
            PG8_WAIT_L(8); PG8_BAR; PG8_WAIT_L(0); PG8_MMA(0, 0, At, B0); PG8_BAR; PG8_SCHED;
            PG8_LDB(B1, 1, 1); PG8_STAGE(PG8_SB(1, 0), b3, voffB);
            PG8_BAR; PG8_WAIT_L(0); PG8_MMA(0, 1, At, B1); PG8_BAR;
            PG8_LDA(At, 1, 1); PG8_STAGE(PG8_SA(1, 0), a3, voffA);
            PG8_BAR; PG8_WAIT_L(0); PG8_MMA(1, 0, At, B0); PG8_BAR; PG8_SCHED;
            PG8_STAGE(PG8_SB(1, 1), b3 + hstep, voffB);
            PG8_WAIT_V(6); PG8_BAR; PG8_MMA(1, 1, At, B1); PG8_BAR;
            }
        }
        if constexpr (ALIGN_EPI) { if (wr == 0) PG8_BAR; }
        if constexpr (!Epi::AFTER_DRAIN) { E(acc, cur, wr, wc, fr, fq); S.done(cur); }
        if (!has_next) break;
#pragma unroll
        for (int a = 0; a < 2; ++a)
#pragma unroll
            for (int b = 0; b < 2; ++b)
#pragma unroll
                for (int m = 0; m < 4; ++m)
#pragma unroll
                    for (int n = 0; n < 2; ++n) acc[a][b][m][n] = (f32x4){0.f, 0.f, 0.f, 0.f};
        cur = nxt; cA = nA; cB = nB; ++ui;
        if constexpr (ALIGN_EPI) { if (wr == 1) PG8_BAR; }
    }
    PG8_WAIT_V(0);
    if constexpr (!ALIGN_EPI) { if (wr == 0) PG8_BAR; }
    PG8_BAR;
    if constexpr (Epi::AFTER_DRAIN) { E.fused(acc, cur, wr, wc, fr, fq, lds, wid, lane); S.done(cur); }
#undef PG8_SA
#undef PG8_SB
#undef PG8_STAGE
#undef PG8_LDA
#undef PG8_LDB
#undef PG8_MMA
#undef PG8_WAIT_V
#undef PG8_WAIT_L
#undef PG8_BAR
#undef PG8_SCHED
}
}
#define LAS __attribute__((address_space(3)))
typedef float f32x4 __attribute__((ext_vector_type(4)));
constexpr int XSPLIT_TILE_ROWS = pg8::XSPLIT_TILE * 256;
#define XB_TMO      128
#define XB_XCNT(j)  (256  + 64 * (j))
#define XB_XSUB(j)  (1280 + 64 * (j))
#define XB_XGEN(j)  (2304 + 64 * (j))
#define XB_TOP      3328
#define XB_TOPGEN   3392
#define XCD_BAR_WORDS 3456
#define XB_SPIN_CAP (1u << 18)

__device__ __forceinline__ unsigned xb_ld(unsigned* p)              { return __hip_atomic_load(p, __ATOMIC_RELAXED, __HIP_MEMORY_SCOPE_AGENT); }
__device__ __forceinline__ unsigned xb_add(unsigned* p, unsigned v) { return __hip_atomic_fetch_add(p, v, __ATOMIC_RELAXED, __HIP_MEMORY_SCOPE_AGENT); }
__device__ __forceinline__ unsigned xb_xcc_id() { return (unsigned)__builtin_amdgcn_s_getreg((3 << 11) | 20) & 0xFu; }
#define XB_SPIN(cond, bar) do { unsigned _sp = 0; while (cond) { __builtin_amdgcn_s_sleep(1); \
    if ((++_sp & 255u) == 0u) { if (xb_ld(&(bar)[XB_TMO])) break; if (_sp > XB_SPIN_CAP) { atomicAdd(&(bar)[XB_TMO], 1u); break; } } } } while (0)

struct XcdBarrier {
    unsigned* bar; unsigned x;
    volatile LAS unsigned* st;
};

__device__ __forceinline__ XcdBarrier xcd_barrier_post(unsigned* bar, volatile LAS unsigned* st) {
    XcdBarrier b; b.bar = bar; b.x = xb_xcc_id(); b.st = st;
    if (threadIdx.x == 0) (void)xb_add(&bar[XB_XCNT(b.x)], 1u);
    return b;
}
__device__ __forceinline__ void xcd_barrier_complete(unsigned* bar, unsigned x, unsigned& nloc, unsigned& nx) {
    const unsigned G = gridDim.x * gridDim.y * gridDim.z;
    unsigned sum, cnt, mine, sp = 0u;
    for (;;) {
        sum = 0u; cnt = 0u; mine = 0u;
#pragma unroll
        for (unsigned j = 0; j < 16; ++j) { const unsigned c = xb_ld(&bar[XB_XCNT(j)]); sum += c; cnt += (c > 0u) ? 1u : 0u; mine = (j == x) ? c : mine; }
        if (sum == G) break;
        __builtin_amdgcn_s_sleep(1);
        if ((++sp & 255u) == 0u) { if (xb_ld(&bar[XB_TMO])) break; if (sp > XB_SPIN_CAP) { atomicAdd(&bar[XB_TMO], 1u); break; } }
    }
    nloc = mine > 0u ? mine : 1u; nx = cnt > 0u ? cnt : 1u;
}

__device__ __forceinline__ void xcd_barrier(const XcdBarrier& b) {
    asm volatile("s_waitcnt vmcnt(0)" ::: "memory");
    __syncthreads();
    if (threadIdx.x == 0) {
        unsigned* bar = b.bar;
        __builtin_amdgcn_s_waitcnt(0);
        unsigned nloc = b.st[0], nx = b.st[1];
        if (nloc == 0u) { xcd_barrier_complete(bar, b.x, nloc, nx); b.st[0] = nloc; b.st[1] = nx; }
        const unsigned old = xb_add(&bar[XB_XSUB(b.x)], 1u);
        const unsigned gen = old / nloc;
        if (old + 1u == (gen + 1u) * nloc) {
            __builtin_amdgcn_fence(__ATOMIC_RELEASE, "agent");
            asm volatile("s_waitcnt vmcnt(0)" ::: "memory");
            const unsigned og = xb_add(&bar[XB_TOP], 1u);
            const unsigned tg = og / nx;
            if (og + 1u == (tg + 1u) * nx) xb_add(&bar[XB_TOPGEN], 1u);
            else XB_SPIN(xb_ld(&bar[XB_TOPGEN]) == tg, bar);
            __builtin_amdgcn_fence(__ATOMIC_ACQUIRE, "agent");
            xb_add(&bar[XB_XGEN(b.x)], 1u);
            asm volatile("s_waitcnt vmcnt(0)" ::: "memory");
        } else {
            XB_SPIN(xb_ld(&bar[XB_XGEN(b.x)]) == gen, bar);
            __builtin_amdgcn_fence(__ATOMIC_ACQUIRE, "agent");
            asm volatile("s_waitcnt vmcnt(0)" ::: "memory");
        }
    }
    __syncthreads();
}

constexpr int NWAVES = 8, NTHREADS = 512;
#ifndef MK_ONE_LAUNCH
#define MK_ONE_LAUNCH 1
#endif
constexpr int D = 1024, DFF = 2816, NBATCH = 8, SEQ = 2048, DEC_B = 128, DEC_T = 4, NMETA = 16, NH = 4, DH = 128, DLRU = 512;
constexpr int R_SAMPLE = 16384, R_META = 16896, N_REAL = 16912, MP = 17152;
constexpr int NZ = 3072, NWIN = 3328, NUP = 5632;
constexpr float EPS = 1e-6f;
constexpr size_t O_YP = 0, O_YS = 16777216, O_PC = O_YS + 524288, O_PN = O_PC + 1048576, O_PM = O_PN + 8192, O_PH = O_PM + 64, O_PCONV = O_PH + 8192,
                 O_SC = O_PCONV + 24576, O_SN = O_SC + 16777216, O_SM = O_SN + 131072, O_SH = O_SM + 1024, O_SCONV = O_SH + 131072, O_END = O_SCONV + 393216;
constexpr size_t MiB = 1u << 20;
constexpr size_t WS_CTL = 0, CTL_ZERO_BYTES = 1 * MiB, WS_XTAIL = 1 * MiB, WS_G = 2 * MiB, WS_WB = 3 * MiB;
constexpr size_t LW_U1 = 0, LW_D1 = 11534336, LW_IN = 17301504, LW_O = 24117248, LW_U2 = 26214400, LW_D2 = 37748736, LW_SIZE = 43515904;
constexpr size_t WS_XN = 87 * MiB, WS_MIX = 121 * MiB, WS_HZ = 155 * MiB, WS_END = 256 * MiB;
static_assert(WS_WB + 2 * LW_SIZE <= WS_XN && WS_XN + (size_t)MP * D * 2 <= WS_MIX && WS_MIX + (size_t)MP * D * 2 <= WS_HZ && WS_HZ + (size_t)MP * NZ * 2 <= WS_END && (size_t)MP * DFF * 2 <= (size_t)MP * NZ * 2, "d_ws map");
constexpr int CW_BAR = 4096;
constexpr int RING_BYTES = 131072, LDSCTL_OFF = RING_BYTES, MISC_OFF = LDSCTL_OFF + 320, LDS_BYTES = 147456;

typedef unsigned short bf16;
typedef unsigned v4u __attribute__((ext_vector_type(4)));
typedef unsigned v2u __attribute__((ext_vector_type(2)));
#define LDS_WAIT() asm volatile("s_waitcnt lgkmcnt(0)" ::: "memory")
__device__ __forceinline__ unsigned f2bf(float f) { unsigned u = __builtin_bit_cast(unsigned, f); return (u + 0x7fffu + ((u >> 16) & 1u)) >> 16; }
__device__ __forceinline__ unsigned pk2(float lo, float hi) { return f2bf(lo) | (f2bf(hi) << 16); }
__device__ __forceinline__ float bf2f(bf16 v) { return __builtin_bit_cast(float, (unsigned)v << 16); }
__device__ __forceinline__ float wave_sum(float v) {
#pragma unroll
    for (int o = 1; o < 64; o <<= 1) v += __shfl_xor(v, o);
    return v;
}
__device__ __forceinline__ float sigmoid_f(float x) { return 1.0f / (1.0f + expf(-x)); }
__device__ __forceinline__ float softplus_f(float x) { return fmaxf(x, 0.f) + log1pf(expf(-fabsf(x))); }
__device__ __forceinline__ float gelu_tanh_f(float x) { const float u = 0.7978845608028654f * (x + 0.044715f * x * x * x); return 0.5f * x * (1.0f + tanhf(u)); }

struct Args { const float* in[30]; float* out; unsigned char* ws; int ph_lo, ph_hi, li, pad; };
struct Ctx { volatile LAS unsigned* tab; float* out; unsigned char* ws; };
__device__ __forceinline__ const float* inp(const Ctx& a, int i) { const unsigned lo = __builtin_amdgcn_readfirstlane(a.tab[2 * i]), hi = __builtin_amdgcn_readfirstlane(a.tab[2 * i + 1]); return (const float*)(((unsigned long long)hi << 32) | lo); }
enum { I_XP = 0, I_XS, I_SC, I_SN, I_SM, I_SH, I_SCONV, I_META, I_GFF1, I_W1G, I_W1U, I_W1D, I_GMIX, I_WIN, I_BG, I_CW, I_CB, I_WRA, I_BRA, I_WRX, I_BRX, I_LAM, I_GMO, I_GLO, I_WOUT, I_GFF2, I_W2G, I_W2U, I_W2D, I_GFIN };

__device__ __forceinline__ float* xrow_ptr(const Ctx& a, int r) { return r < XSPLIT_TILE_ROWS ? a.out + (size_t)r * D : (float*)(a.ws + WS_XTAIL) + (size_t)(r - XSPLIT_TILE_ROWS) * D; }

__device__ __forceinline__ void conv_item(const float* W, int K, int Nsrc, int sc0, int nvalid, const float* gamma, float rs, bf16* WT, int n0, int k0, LAS float* scr, int lane) {
#pragma unroll 8
    for (int i = 0; i < 32; ++i) { const int kk = 2 * i + (lane >> 5), j = lane & 31; float v = 0.f;
        if (j < nvalid) { v = W[(size_t)(k0 + kk) * Nsrc + sc0 + j] * rs; if (gamma) v *= gamma[k0 + kk]; }
        scr[kk * 33 + j] = v; }
    LDS_WAIT(); asm volatile("" ::: "memory");
    const int c = lane & 7;
#pragma unroll
    for (int j = 0; j < 4; ++j) { const int n = (lane >> 3) + 8 * j; const LAS float* s = scr + (8 * c) * 33 + n;
        v4u o; o.x = pk2(s[0 * 33], s[1 * 33]); o.y = pk2(s[2 * 33], s[3 * 33]); o.z = pk2(s[4 * 33], s[5 * 33]); o.w = pk2(s[6 * 33], s[7 * 33]);
        *(v4u*)(WT + (size_t)(n0 + n) * K + k0 + 8 * c) = o; }
    LDS_WAIT(); asm volatile("" ::: "memory");
}
constexpr int IT_U = 16 * 176, IT_D = 44 * 32, IT_IN = 16 * 104, IT_O = 16 * 32, IT_LAYER = 2 * IT_U + 2 * IT_D + IT_IN + IT_O;
__device__ __forceinline__ void conv_dispatch(const Ctx& a, int it, LAS float* scr, int lane) {
    const int l = it / IT_LAYER; int r = it % IT_LAYER;
    unsigned char* wb = a.ws + WS_WB + (size_t)l * LW_SIZE;
    if (r < 2 * IT_U) {
        const int second = r >= IT_U; if (second) r -= IT_U;
        const int nb = r % 176, kb = r / 176, n0 = nb * 32, grp = n0 >> 8, w = n0 & 255;
        const float* src = inp(a, second ? (w < 128 ? I_W2G : I_W2U) : (w < 128 ? I_W1G : I_W1U)) + (size_t)l * D * DFF;
        conv_item(src, D, DFF, grp * 128 + (w & 127), 32, inp(a, second ? I_GFF2 : I_GFF1) + l * D, 1.f, (bf16*)(wb + (second ? LW_U2 : LW_U1)), n0, kb * 64, scr, lane);
        return; }
    r -= 2 * IT_U;
    if (r < 2 * IT_D) {
        const int second = r >= IT_D; if (second) r -= IT_D;
        const int nb = r % 32, kb = r / 32;
        conv_item(inp(a, second ? I_W2D : I_W1D) + (size_t)l * DFF * D, DFF, D, nb * 32, 32, nullptr, 1.f, (bf16*)(wb + (second ? LW_D2 : LW_D1)), nb * 32, kb * 64, scr, lane);
        return; }
    r -= 2 * IT_D;
    if (r < IT_IN) {
        const int nb = r % 104, kb = r / 104, n0 = nb * 32; int sc0, nvalid = 32; float rs = 1.f;
        if (n0 < 2048) { sc0 = n0; if (n0 >= 512 && n0 < 1024) rs = 0.08838834764831845f; }
        else if (n0 < 3072) sc0 = n0 + 8;
        else if (n0 == 3072) { sc0 = 2048; nvalid = 8; }
        else { sc0 = 0; nvalid = 0; }
        conv_item(inp(a, I_WIN) + (size_t)l * D * 3080, D, 3080, sc0, nvalid, inp(a, I_GMIX) + l * D, rs, (bf16*)(wb + LW_IN), n0, kb * 64, scr, lane);
        return; }
    r -= IT_IN;
    { const int nb = r % 32, kb = r / 32;
      conv_item(inp(a, I_WOUT) + (size_t)l * D * D, D, D, nb * 32, 32, nullptr, 1.f, (bf16*)(wb + LW_O), nb * 32, kb * 64, scr, lane); }
}
__device__ __forceinline__ void norm_row_to_bf16(const float* xrow, bf16* orow, int lane) {
    const f32x4* xr = (const f32x4*)xrow + lane; f32x4 v[4]; float s = 0.f;
#pragma unroll
    for (int j = 0; j < 4; ++j) { v[j] = xr[64 * j]; s += (v[j].x * v[j].x + v[j].y * v[j].y) + (v[j].z * v[j].z + v[j].w * v[j].w); }
    const float rstd = 1.f / sqrtf(wave_sum(s) * (1.f / D) + EPS);
    unsigned long long* o8 = (unsigned long long*)orow + lane;
#pragma unroll
    for (int j = 0; j < 4; ++j) o8[64 * j] = (unsigned long long)pk2(v[j].x * rstd, v[j].y * rstd) | ((unsigned long long)pk2(v[j].z * rstd, v[j].w * rstd) << 32);
}

__device__ __forceinline__ void mlstm_naive_item(const Ctx& a, int l, int item, LAS float* sm, int tid) {
    const int lane = tid & 63, wave = tid >> 6, e = tid >> 2, qd = tid & 3, d0 = 32 * qd;
    const bool prompt = item < 32; const int b = prompt ? item >> 2 : (item - 32) >> 2, h = prompt ? item & 3 : (item - 32) & 3;
    const bf16* Z = (const bf16*)(a.ws + WS_HZ); const float* G = (const float*)(a.ws + WS_G); bf16* MIX = (bf16*)(a.ws + WS_MIX);
    LAS float* qs = sm; LAS float* ks = sm + 128; LAS float* red = sm + 256; LAS float* red2 = sm + 264;
    float C[32]; float nreg = 0.f, m = 0.f;
#pragma unroll
    for (int j = 0; j < 32; ++j) C[j] = 0.f;
    if (!prompt) {
        const float* C0 = inp(a, I_SC) + ((size_t)(l * DEC_B + b) * NH + h) * DH * DH + (size_t)e * DH + d0;
#pragma unroll
        for (int j = 0; j < 32; ++j) C[j] = C0[j];
        if (tid < 128) nreg = inp(a, I_SN)[((size_t)(l * DEC_B + b) * NH + h) * DH + tid];
        m = inp(a, I_SM)[(l * DEC_B + b) * NH + h];
    }
    const float big = inp(a, I_BG)[l * 8 + h], bfg = inp(a, I_BG)[l * 8 + 4 + h];
    const float gm = inp(a, I_GMO)[l * 512 + h * DH + e];
    const int nsteps = prompt ? NMETA + SEQ : DEC_T;
    for (int t = 0; t < nsteps; ++t) {
        const int row = prompt ? (t < NMETA ? R_META + t : b * SEQ + (t - NMETA)) : R_SAMPLE + b * DEC_T + t;
        const bf16* zr = Z + (size_t)row * NZ;
        if (tid < 128) { qs[tid] = bf2f(zr[h * DH + tid]); ks[tid] = bf2f(zr[512 + h * DH + tid]); }
        const float ve = bf2f(zr[1024 + h * DH + e]), oe = bf2f(zr[1536 + h * DH + e]);
        const float ig = G[(size_t)row * 8 + h] + big, fg = G[(size_t)row * 8 + 4 + h] + bfg;
        const float logf = -softplus_f(-fg);
        const float mn = fmaxf(logf + m, ig), decay = expf(logf + m - mn), igw = expf(ig - mn);
        m = mn;
        __syncthreads();
        float num = 0.f; const float iv = igw * ve;
#pragma unroll
        for (int j = 0; j < 32; ++j) { C[j] = decay * C[j] + iv * ks[d0 + j]; num += C[j] * qs[d0 + j]; }
        num += __shfl_xor(num, 1); num += __shfl_xor(num, 2);
        float pd = 0.f;
        if (tid < 128) { nreg = decay * nreg + igw * ks[tid]; pd = nreg * qs[tid]; }
        if (wave < 2) { pd = wave_sum(pd); if (lane == 0) red[wave] = pd; }
        __syncthreads();
        const float den = red[0] + red[1];
        const float hv = num / fmaxf(fabsf(den), expf(-mn));
        float sq = (qd == 0) ? hv * hv : 0.f; sq = wave_sum(sq); if (lane == 0) red2[wave] = sq;
        __syncthreads();
        float ss = 0.f;
#pragma unroll
        for (int w = 0; w < 8; ++w) ss += red2[w];
        if (qd == 0 && (!prompt || t >= NMETA || b == 0)) {
            const float y = hv * (1.0f / sqrtf(ss * (1.f / DH) + EPS)) * gm * sigmoid_f(oe);
            MIX[(size_t)row * D + h * DH + e] = (bf16)f2bf(y);
        }
    }
    float* oC = a.out + (prompt ? O_PC + ((size_t)(l * NBATCH + b) * NH + h) * DH * DH : O_SC + ((size_t)(l * DEC_B + b) * NH + h) * DH * DH) + (size_t)e * DH + d0;
#pragma unroll
    for (int j = 0; j < 32; ++j) oC[j] = C[j];
    if (tid < 128) a.out[(prompt ? O_PN + ((size_t)(l * NBATCH + b) * NH + h) * DH : O_SN + ((size_t)(l * DEC_B + b) * NH + h) * DH) + tid] = nreg;
    if (tid == 0) a.out[prompt ? O_PM + (l * NBATCH + b) * NH + h : O_SM + (l * DEC_B + b) * NH + h] = m;
    __syncthreads();
}
__device__ __forceinline__ void lru_naive_item(const Ctx& a, int l, int item, LAS float* sm, int tid) {
    const int lane = tid & 63, wave = tid >> 6, c = tid;
    const bool prompt = item < 8; const int b = prompt ? item : item - 8;
    const bf16* Z = (const bf16*)(a.ws + WS_HZ); bf16* MIX = (bf16*)(a.ws + WS_MIX);
    LAS float* red = sm + 33024;
    LAS float* wxs = sm + wave * 4096 + lane;
    float wa[64];
    { const float* pa = inp(a, I_WRA) + (size_t)(l * 8 + wave) * 4096 + lane; const float* px = inp(a, I_WRX) + (size_t)(l * 8 + wave) * 4096 + lane;
#pragma unroll
      for (int d = 0; d < 64; ++d) { wa[d] = pa[d * 64]; wxs[d * 64] = px[d * 64]; } }
    const float cw0 = inp(a, I_CW)[(l * 4 + 0) * 512 + c], cw1 = inp(a, I_CW)[(l * 4 + 1) * 512 + c], cw2 = inp(a, I_CW)[(l * 4 + 2) * 512 + c], cw3 = inp(a, I_CW)[(l * 4 + 3) * 512 + c];
    const float cb = inp(a, I_CB)[l * 512 + c], ba = inp(a, I_BRA)[l * 512 + c], bx = inp(a, I_BRX)[l * 512 + c];
    const float sp = 8.0f * softplus_f(-inp(a, I_LAM)[l * 512 + c]), gl = inp(a, I_GLO)[l * 512 + c];
    float x3 = 0.f, x2 = 0.f, x1 = 0.f, hst = 0.f;
    if (!prompt) { const float* cs = inp(a, I_SCONV) + (size_t)(l * DEC_B + b) * 3 * 512; x3 = cs[c]; x2 = cs[512 + c]; x1 = cs[1024 + c]; hst = inp(a, I_SH)[(size_t)(l * DEC_B + b) * 512 + c]; }
    const int nsteps = prompt ? NMETA + SEQ : DEC_T;
    for (int t = 0; t < nsteps; ++t) {
        const int row = prompt ? (t < NMETA ? R_META + t : b * SEQ + (t - NMETA)) : R_SAMPLE + b * DEC_T + t;
        const bf16* zr = Z + (size_t)row * NZ;
        const float x0 = bf2f(zr[2048 + c]), yg = bf2f(zr[2560 + c]);
        const float xc = cb + x3 * cw0 + x2 * cw1 + x1 * cw2 + x0 * cw3;
        float ra = ba, ri = bx;
#pragma unroll
        for (int d = 0; d < 64; ++d) { const float xd = __builtin_bit_cast(float, __builtin_amdgcn_readlane(__builtin_bit_cast(int, xc), d)); ra += xd * wa[d]; ri += xd * wxs[d * 64]; }
        const float r = sigmoid_f(ra), ig = sigmoid_f(ri);
        const float log_a = -sp * r, av = expf(log_a), bin = sqrtf(-expm1f(2.0f * log_a)) * (ig * xc);
        hst = av * hst + bin;
        float sq = wave_sum(hst * hst); LAS float* rp = red + (t & 1) * 8; if (lane == 0) rp[wave] = sq;
        __syncthreads();
        float ss = 0.f;
#pragma unroll
        for (int w = 0; w < 8; ++w) ss += rp[w];
        if (!prompt || t >= NMETA || b == 0) {
            const float y = hst * (1.0f / sqrtf(ss * (1.f / 512.f) + EPS)) * gl * gelu_tanh_f(yg);
            MIX[(size_t)row * D + 512 + c] = (bf16)f2bf(y);
        }
        x3 = x2; x2 = x1; x1 = x0;
    }
    if (prompt) { a.out[O_PH + (size_t)(l * NBATCH + b) * 512 + c] = hst; float* pc = a.out + O_PCONV + (size_t)(l * NBATCH + b) * 3 * 512; pc[c] = x3; pc[512 + c] = x2; pc[1024 + c] = x1; }
    else { a.out[O_SH + (size_t)(l * DEC_B + b) * 512 + c] = hst; float* pc = a.out + O_SCONV + (size_t)(l * DEC_B + b) * 3 * 512; pc[c] = x3; pc[512 + c] = x2; pc[1024 + c] = x1; }
    __syncthreads();
}


constexpr size_t AG_LA = 0, AG_LH = 1 * MiB, AG_DC = 2 * MiB, AG_DN = AG_DC + (size_t)260 * 65536, AG_SC = AG_DN + (size_t)260 * 512, AG_END = AG_SC + 260 * 8;
static_assert(AG_END <= (size_t)MP * D * 2 && (size_t)257 * 512 * 4 <= MiB, "aggregate scratch fits the XN region");
typedef short bf16x8_t __attribute__((ext_vector_type(8)));
typedef short bf16x4_t __attribute__((ext_vector_type(4)));
constexpr int LRU_UNITS = 257;

template <int MODE>
__device__ __forceinline__ void lru_unit(const Ctx& a, int l, int unit, LAS unsigned char* lds, int tid) {
    const int lane = tid & 63, w = __builtin_amdgcn_readfirstlane(tid >> 6), fr = lane & 15, g = lane >> 4;
    const bool meta = unit == 0; const int b = meta ? 0 : (unit - 1) >> 5, c = meta ? 0 : (unit - 1) & 31;
    const int row0 = meta ? R_META : b * SEQ + c * 64, nvalid = meta ? NMETA : 64;
    const bf16* Z = (const bf16*)(a.ws + WS_HZ); bf16* MIX = (bf16*)(a.ws + WS_MIX);
    float* LA = (float*)(a.ws + WS_XN + AG_LA); float* LH = (float*)(a.ws + WS_XN + AG_LH);
    LAS bf16* xcS = (LAS bf16*)(lds + w * 4608);
    LAS float* ssS = (LAS float*)(lds + 36864);
    const int chg = 64 * w + lane;
    const float cw0 = inp(a, I_CW)[(l * 4 + 0) * 512 + chg], cw1 = inp(a, I_CW)[(l * 4 + 1) * 512 + chg], cw2 = inp(a, I_CW)[(l * 4 + 2) * 512 + chg], cw3 = inp(a, I_CW)[(l * 4 + 3) * 512 + chg];
    const float cb = inp(a, I_CB)[l * 512 + chg];
    float ba[4], bx[4], sp[4], gl[4];
#pragma unroll
    for (int n = 0; n < 4; ++n) { const int cd = 64 * w + 16 * n + fr; ba[n] = inp(a, I_BRA)[l * 512 + cd]; bx[n] = inp(a, I_BRX)[l * 512 + cd];
        sp[n] = 8.0f * softplus_f(-inp(a, I_LAM)[l * 512 + cd]); gl[n] = inp(a, I_GLO)[l * 512 + cd]; }
    bf16x8_t wfA[4][2], wfX[4][2];
    { const float* pa = inp(a, I_WRA) + (size_t)(l * 8 + w) * 4096; const float* px = inp(a, I_WRX) + (size_t)(l * 8 + w) * 4096;
#pragma unroll
      for (int n = 0; n < 4; ++n)
#pragma unroll
        for (int kk = 0; kk < 2; ++kk)
#pragma unroll
            for (int j = 0; j < 8; ++j) { const int d = 32 * kk + 8 * g + j, e = 16 * n + fr; wfA[n][kk][j] = (short)f2bf(pa[d * 64 + e]); wfX[n][kk][j] = (short)f2bf(px[d * 64 + e]); } }
    float x3 = 0.f, x2 = 0.f, x1 = 0.f;
    if (!meta) { const int p3 = c == 0 ? R_META + 13 : row0 - 3;
        x3 = bf2f(Z[(size_t)p3 * NZ + 2048 + chg]); x2 = bf2f(Z[(size_t)(p3 + 1) * NZ + 2048 + chg]); x1 = bf2f(Z[(size_t)(p3 + 2) * NZ + 2048 + chg]); }
    float hin[4] = {0.f, 0.f, 0.f, 0.f}, Atot[4] = {1.f, 1.f, 1.f, 1.f};
    if (MODE == 1 && !meta) {
#pragma unroll
        for (int n = 0; n < 4; ++n) { const int cd = 64 * w + 16 * n + fr; float h = LH[cd];
            for (int cc = 0; cc < c; ++cc) { const int u = 1 + b * 32 + cc; h = LA[(size_t)u * 512 + cd] * h + LH[(size_t)u * 512 + cd]; }
            hin[n] = h; }
    }
    const int nhalf = meta ? 1 : 2;
    for (int hh = 0; hh < nhalf; ++hh) {
        for (int tt = 0; tt < 32; ++tt) { const int tok = 32 * hh + tt; float x0 = 0.f;
            if (tok < nvalid) x0 = bf2f(Z[(size_t)(row0 + tok) * NZ + 2048 + chg]);
            const float xc = cb + x3 * cw0 + x2 * cw1 + x1 * cw2 + x0 * cw3;
            xcS[tt * 72 + lane] = (bf16)f2bf(xc);
            if (tok < nvalid) { x3 = x2; x2 = x1; x1 = x0; } }
        LDS_WAIT(); asm volatile("" ::: "memory");
#pragma unroll 1
        for (int m = 0; m < 2; ++m) {
            float hval[4][4];
            f32x4 accR[4], accI[4];
#pragma unroll
            for (int n = 0; n < 4; ++n) { accR[n] = (f32x4){0.f, 0.f, 0.f, 0.f}; accI[n] = (f32x4){0.f, 0.f, 0.f, 0.f}; }
#pragma unroll
            for (int kk = 0; kk < 2; ++kk) { const bf16x8_t af = *(const LAS bf16x8_t*)(xcS + (16 * m + fr) * 72 + 32 * kk + 8 * g);
#pragma unroll
                for (int n = 0; n < 4; ++n) { accR[n] = __builtin_amdgcn_mfma_f32_16x16x32_bf16(af, wfA[n][kk], accR[n], 0, 0, 0); accI[n] = __builtin_amdgcn_mfma_f32_16x16x32_bf16(af, wfX[n][kk], accI[n], 0, 0, 0); } }
#pragma unroll
            for (int n = 0; n < 4; ++n) {
                float av[4], bv[4];
#pragma unroll
                for (int i = 0; i < 4; ++i) { const int tt = 16 * m + 4 * g + i, tok = 32 * hh + tt;
                    const float r = sigmoid_f(accR[n][i] + ba[n]), ig = sigmoid_f(accI[n][i] + bx[n]);
                    const float log_a = -sp[n] * r, xcv = bf2f(xcS[tt * 72 + 16 * n + fr]);
                    const bool valid = tok < nvalid;
                    av[i] = valid ? expf(log_a) : 1.f; bv[i] = valid ? sqrtf(-expm1f(2.0f * log_a)) * (ig * xcv) : 0.f; }
                float Al = av[0], Hl = bv[0];
#pragma unroll
                for (int i = 1; i < 4; ++i) { Hl = av[i] * Hl + bv[i]; Al *= av[i]; }
                const float A1 = __shfl_xor(Al, 16), H1 = __shfl_xor(Hl, 16);
                const bool odd = g & 1;
                const float Apair = Al * A1, Hpair = odd ? (Al * H1 + Hl) : (A1 * Hl + H1);
                const float Awin = odd ? A1 : 1.f, Hwin = odd ? H1 : 0.f;
                const float A2 = __shfl_xor(Apair, 32), H2 = __shfl_xor(Hpair, 32);
                const bool hi = g & 2;
                const float Apre = hi ? A2 * Awin : Awin, Hpre = hi ? (Awin * H2 + Hwin) : Hwin;
                const float At = Apair * A2, Ht = hi ? (Apair * H2 + Hpair) : (A2 * Hpair + H2);
                if (MODE == 1) { float hs = Apre * hin[n] + Hpre;
#pragma unroll
                    for (int i = 0; i < 4; ++i) { hs = av[i] * hs + bv[i]; hval[n][i] = hs; } }
                hin[n] = At * hin[n] + Ht; Atot[n] *= At;
            }
            if (MODE == 1) {
#pragma unroll
                for (int i = 0; i < 4; ++i) { float s = 0.f;
#pragma unroll
                    for (int n = 0; n < 4; ++n) s += hval[n][i] * hval[n][i];
                    s += __shfl_xor(s, 1); s += __shfl_xor(s, 2); s += __shfl_xor(s, 4); s += __shfl_xor(s, 8);
                    if (fr == 0) ssS[(m * 8 + w) * 32 + 4 * g + i] = s; }
                __syncthreads();
#pragma unroll
                for (int i = 0; i < 4; ++i) { const int tt = 16 * m + 4 * g + i, tok = 32 * hh + tt; float ss = 0.f;
#pragma unroll
                    for (int ww = 0; ww < 8; ++ww) ss += ssS[(m * 8 + ww) * 32 + 4 * g + i];
                    const float inv = 1.0f / sqrtf(ss * (1.f / 512.f) + EPS);
                    if (tok < nvalid) { const unsigned row = (unsigned)(row0 + tok);
#pragma unroll
                        for (int n = 0; n < 4; ++n) { const unsigned cd = 64 * w + 16 * n + fr; const float yg = bf2f(Z[row * NZ + 2560 + cd]);
                            MIX[row * D + 512 + cd] = (bf16)f2bf(hval[n][i] * inv * gl[n] * gelu_tanh_f(yg)); } } }
            }
        }
        asm volatile("" ::: "memory");
    }
    if (MODE == 0) { if (g == 0) {
#pragma unroll
        for (int n = 0; n < 4; ++n) { const int cd = 64 * w + 16 * n + fr; LA[(size_t)unit * 512 + cd] = Atot[n]; LH[(size_t)unit * 512 + cd] = hin[n]; } } }
    else if (!meta && c == 31) {
        if (g == 0) {
#pragma unroll
            for (int n = 0; n < 4; ++n) a.out[O_PH + (size_t)(l * NBATCH + b) * 512 + 64 * w + 16 * n + fr] = hin[n]; }
        float* pc = a.out + O_PCONV + (size_t)(l * NBATCH + b) * 3 * 512; pc[chg] = x3; pc[512 + chg] = x2; pc[1024 + chg] = x1;
    }
    __syncthreads();
}

constexpr int N_PHASES = 23;
constexpr int TAB_OFF = MISC_OFF + 128;
static_assert(TAB_OFF + 256 <= LDS_BYTES, "LDS map");
__global__ void __launch_bounds__(NTHREADS, 2) mega_fwd(Args args) {
    extern __shared__ __attribute__((aligned(16))) unsigned char lds_raw[];
    LAS unsigned char* lds = (LAS unsigned char*)lds_raw;
    volatile LAS unsigned* MISC = (volatile LAS unsigned*)(lds + MISC_OFF);
    const int tid0 = threadIdx.x;
    for (int u = tid0; u < (LDS_BYTES - LDSCTL_OFF) / 4; u += NTHREADS) ((LAS unsigned*)(lds + LDSCTL_OFF))[u] = 0u;
    __syncthreads();
    if (tid0 == 0) {
        volatile LAS unsigned* tab = (volatile LAS unsigned*)(lds + TAB_OFF);
#pragma unroll
        for (int i = 0; i < 30; ++i) { const unsigned long long v = (unsigned long long)args.in[i]; tab[2 * i] = (unsigned)v; tab[2 * i + 1] = (unsigned)(v >> 32); }
    }
    __syncthreads();
    XcdBarrier bar; bar.bar = (unsigned*)(args.ws + WS_CTL) + CW_BAR; bar.x = 0; bar.st = nullptr;
    if ((args.ph_hi - args.ph_lo) > 1) bar = xcd_barrier_post((unsigned*)(args.ws + WS_CTL) + CW_BAR, MISC + 8);

    for (int p = args.ph_lo; p < args.ph_hi; ++p) {
        if (p > args.ph_lo) { XcdBarrier b2 = bar; asm volatile("" : "+s"(b2.bar), "+s"(b2.x)); xcd_barrier(b2); }
        Ctx cx; { unsigned tv = (unsigned)(size_t)(lds + TAB_OFF); asm volatile("" : "+v"(tv)); cx.tab = (volatile LAS unsigned*)(size_t)tv; } cx.out = args.out; cx.ws = args.ws;
        int G = gridDim.x, bx = blockIdx.x, tid = tid0;
        asm volatile("" : "+s"(cx.out), "+s"(cx.ws), "+s"(G), "+s"(bx), "+v"(tid));
        unsigned char* ws = cx.ws;
        const int lane = tid & 63, wave = __builtin_amdgcn_readfirstlane(tid >> 6);
        const int vcu = (G % 8 == 0) ? (bx % 8) * (G / 8) + bx / 8 : bx;
        const int gw = vcu * NWAVES + wave, NGW = G * NWAVES;
        bf16* XN = (bf16*)(ws + WS_XN); bf16* MIX = (bf16*)(ws + WS_MIX); bf16* HZ = (bf16*)(ws + WS_HZ); float* GATES = (float*)(ws + WS_G);
        const pg8::XRows XR{cx.out, (float*)(ws + WS_XTAIL)};
        if (p == 0) {
            LAS float* scr = (LAS float*)(lds + wave * 16384);
            for (int it = gw; it < 2 * IT_LAYER; it += NGW) conv_dispatch(cx, it, scr, lane);
            for (int r = gw; r < MP; r += NGW) {
                float* xo = xrow_ptr(cx, r);
                if (r < N_REAL) {
                    const float* src = r < R_SAMPLE ? inp(cx, I_XP) + (size_t)r * D : (r < R_META ? inp(cx, I_XS) + (size_t)(r - R_SAMPLE) * D : inp(cx, I_META) + (size_t)(r - R_META) * D);
#pragma unroll
                    for (int j = 0; j < 4; ++j) ((f32x4*)xo)[lane + 64 * j] = ((const f32x4*)src)[lane + 64 * j];
                    norm_row_to_bf16(src, XN + (size_t)r * D, lane);
                } else {
#pragma unroll
                    for (int j = 0; j < 4; ++j) ((f32x4*)xo)[lane + 64 * j] = (f32x4){0.f, 0.f, 0.f, 0.f};
                    for (int j = 0; j < 2; ++j) { ((v4u*)(XN + (size_t)r * D))[lane + 64 * j] = (v4u){0u, 0u, 0u, 0u}; ((v4u*)(MIX + (size_t)r * D))[lane + 64 * j] = (v4u){0u, 0u, 0u, 0u}; }
                }
            }
            continue;
        }
        const int l = (p - 1) / 11, k = (p - 1) % 11;
        const unsigned char* wb = ws + WS_WB + (size_t)l * LW_SIZE;
        if (k == 0 || k == 8) {
            pg8::Gemm g{XN, (const bf16*)(wb + (k == 0 ? LW_U1 : LW_U2)), MP, NUP, D}; pg8::StaticOrder S; S.init(MP, NUP, G, bx);
            pg8::EpiSwiGLU E{HZ, DFF};
            pg8::gemm_phase<pg8::EpiSwiGLU, pg8::StaticOrder, true, true>(lds, g, S, E, tid);
        } else if (k == 1 || k == 9) {
            pg8::Gemm g{HZ, (const bf16*)(wb + (k == 1 ? LW_D1 : LW_D2)), MP, D, DFF}; pg8::StaticOrder S; S.init(MP, D, G, bx);
            pg8::EpiResid E{XR, 0.5f};
            pg8::gemm_phase<pg8::EpiResid, pg8::StaticOrder, true, true>(lds, g, S, E, tid);
        } else if (k == 6) {
            pg8::Gemm g{MIX, (const bf16*)(wb + LW_O), MP, D, D}; pg8::StaticOrder S; S.init(MP, D, G, bx);
            pg8::EpiResid E{XR, 1.0f};
            pg8::gemm_phase<pg8::EpiResid, pg8::StaticOrder, true, true>(lds, g, S, E, tid);
        } else if (k == 3) {
            pg8::Gemm g{XN, (const bf16*)(wb + LW_IN), MP, NWIN, D}; pg8::StaticOrder S; S.init(MP, NWIN, G, bx);
            pg8::EpiZ E{HZ, GATES};
            pg8::gemm_phase<pg8::EpiZ, pg8::StaticOrder, true, true>(lds, g, S, E, tid);
        } else if (k == 2 || k == 7 || (k == 10 && l == 0)) {
            for (int r = gw; r < MP; r += NGW) norm_row_to_bf16(xrow_ptr(cx, r), XN + (size_t)r * D, lane);
        } else if (k == 10) {
            const float* gfin = inp(cx, I_GFIN);
            for (int r = gw; r < R_META; r += NGW) {
                f32x4* xr = (f32x4*)xrow_ptr(cx, r) + lane; const f32x4* gf = (const f32x4*)gfin + lane; f32x4 v[4]; float s = 0.f;
#pragma unroll
                for (int j = 0; j < 4; ++j) { v[j] = xr[64 * j]; s += (v[j].x * v[j].x + v[j].y * v[j].y) + (v[j].z * v[j].z + v[j].w * v[j].w); }
                const float rstd = 1.f / sqrtf(wave_sum(s) * (1.f / D) + EPS);
#pragma unroll
                for (int j = 0; j < 4; ++j) xr[64 * j] = v[j] * rstd * gf[64 * j];
            }
        } else if (k == 4) {
            for (int it = vcu; it < 32 + DEC_B * NH + LRU_UNITS; it += G) {
                int ll = l, t2 = tid; asm volatile("" : "+s"(ll), "+v"(t2));
                if (it < 32 + DEC_B * NH) mlstm_naive_item(cx, ll, it, (LAS float*)lds, t2);
                else lru_unit<0>(cx, ll, it - (32 + DEC_B * NH), lds, t2);
            }
        } else if (k == 5) {
            for (int it = vcu; it < LRU_UNITS + DEC_B; it += G) {
                int ll = l, t2 = tid; asm volatile("" : "+s"(ll), "+v"(t2));
                if (it < LRU_UNITS) lru_unit<1>(cx, ll, it, lds, t2);
                else lru_naive_item(cx, ll, 8 + (it - LRU_UNITS), (LAS float*)lds, t2);
            }
        }
    }
}

extern "C" void kernel_launch(void* const* d_in, const int* in_sizes, int n_in, void* d_out, int out_size, void* d_ws, size_t ws_size, hipStream_t stream) {
    static int grid = 0;
    if (grid == 0) {
        if (n_in != 30 || out_size != (int)O_END || ws_size < WS_END) { fprintf(stderr, "kernel_launch: unexpected shapes: n_in %d out %d ws %zu\n", n_in, out_size, ws_size); grid = -1; return; }
        int dev = 0, cus = 0, per_cu = 0;
        if (hipGetDevice(&dev) != hipSuccess || hipDeviceGetAttribute(&cus, hipDeviceAttributeMultiprocessorCount, dev) != hipSuccess) { grid = -1; return; }
        if (hipFuncSetAttribute((const void*)mega_fwd, hipFuncAttributeMaxDynamicSharedMemorySize, LDS_BYTES) != hipSuccess) { fprintf(stderr, "kernel_launch: hipFuncSetAttribute failed\n"); grid = -1; return; }
        if (hipOccupancyMaxActiveBlocksPerMultiprocessor(&per_cu, (const void*)mega_fwd, NTHREADS, LDS_BYTES) != hipSuccess || per_cu < 1)
            fprintf(stderr, "kernel_launch: note: occupancy query reports %d workgroups per CU\n", per_cu);
        (void)hipGetLastError();
        grid = cus;
    }
    if (grid < 0) return;
    if (hipMemsetAsync((char*)d_ws + WS_CTL, 0, CTL_ZERO_BYTES, stream) != hipSuccess) { fprintf(stderr, "kernel_launch: hipMemsetAsync failed\n"); return; }
    Args a{};
    for (int i = 0; i < 30; ++i) a.in[i] = (const float*)d_in[i];
    a.out = (float*)d_out; a.ws = (unsigned char*)d_ws;
#if MK_ONE_LAUNCH
    a.ph_lo = 0; a.ph_hi = N_PHASES; a.li = 0;
    hipLaunchKernelGGL(mega_fwd, dim3(grid), dim3(NTHREADS), LDS_BYTES, stream, a);
#else
    for (int p = 0; p < N_PHASES; ++p) { a.ph_lo = p; a.ph_hi = p + 1; a.li = p; hipLaunchKernelGGL(mega_fwd, dim3(grid), dim3(NTHREADS), LDS_BYTES, stream, a); }
#endif
}
```

```cpp
#include <hip/hip_runtime.h>
#include <cstdio>
#include <cstdint>
namespace pg8 {
#define PG8_LAS __attribute__((address_space(3)))
typedef unsigned short bf16_t;
typedef short bf16x8 __attribute__((ext_vector_type(8)));
typedef float f32x4 __attribute__((ext_vector_type(4)));
typedef unsigned u32x4 __attribute__((ext_vector_type(4)));
constexpr int BM = 256, BK = 64, HALF = 128, HTB = HALF * BK * 2  , STAGE_BYTES = 8 * HTB, NXCD = 8, WGM = 8;

__host__ __device__ __forceinline__ int lds_byte(int r, int c) { const int st = (r >> 4) * 2 + (c >> 5), rr = r & 15, cc = c & 31, ob = rr * 64 + cc * 2; return st * 1024 + (ob ^ (((ob >> 9) & 1) << 5)); }
__host__ __device__ __forceinline__ void stage_rc(int b, int& R, int& C) { const int st = b / 1024, sb = b % 1024, swz = sb ^ (((sb >> 9) & 1) << 5); R = (st >> 1) * 16 + swz / 64; C = (st & 1) * 32 + (swz % 64) / 2; }
__host__ __device__ __forceinline__ int perm32(int rho) { const int n = rho >> 4, i = rho & 15; return 8 * (i >> 2) + 4 * n + (i & 3); }

struct Unit { int pm, pn; };
struct Gemm { const bf16_t* A; const bf16_t* Bt; int M, N, K; };

struct StaticOrder {
    int nM, nN, nwg, G, c;
    __host__ __device__ void init(int M, int N, int G_, int c_) { nM = M / BM; nN = N / BM; nwg = nM * nN; G = G_; c = c_; }
    __host__ __device__ bool next(int i, Unit& u) const {
        const long L = (long)i * G + c; if (L >= nwg) return false;
        int wgid = (int)L; { const int q = nwg / NXCD, r = nwg % NXCD, xcd = wgid % NXCD, off = wgid / NXCD; wgid = (xcd < r ? xcd * (q + 1) : r * (q + 1) + (xcd - r) * q) + off; }
        const int nig = WGM * nN, gid = wgid / nig, fm = gid * WGM, gsz = (nM - fm) < WGM ? (nM - fm) : WGM;
        u.pm = fm + ((wgid % nig) % gsz); u.pn = (wgid % nig) / gsz; return true;
    }
    __device__ __forceinline__ void a_ready(const Unit&) const {}
    __device__ __forceinline__ void done(const Unit&) const {}
};


__device__ __forceinline__ unsigned cvt_pk_bf16(float lo, float hi) { unsigned r; asm volatile("v_cvt_pk_bf16_f32 %0, %1, %2" : "=v"(r) : "v"(lo), "v"(hi)); return r; }
__device__ __forceinline__ float silu_f(float g) { return g * __builtin_amdgcn_rcpf(1.0f + __expf(-g)); }

constexpr int XSPLIT_TILE = 66;
struct XRows { float* lo; float* tail; __device__ __forceinline__ float* tile(int pm) const { return pm < XSPLIT_TILE ? lo + (size_t)pm * BM * 1024 : tail + (size_t)(pm - XSPLIT_TILE) * BM * 1024; } };

struct EpiSwiGLU {
    static constexpr bool PERM = true, AFTER_DRAIN = false;
    bf16_t* O; int ldc;
    __device__ __forceinline__ void operator()(const f32x4 (&acc)[2][2][4][2], const Unit& u, int wr, int wc, int fr, int fq) const {
        const int row0 = u.pm * BM + wr * 64 + fr; const int col0 = u.pn * HALF + wc * 32 + 8 * fq;
#pragma unroll
        for (int ai = 0; ai < 2; ++ai)
#pragma unroll
            for (int m = 0; m < 4; ++m) { bf16_t* rowp = O + (size_t)(row0 + ai * HALF + m * 16) * ldc + col0;
                const f32x4 g0 = acc[ai][0][m][0], g1 = acc[ai][0][m][1], u0 = acc[ai][1][m][0], u1 = acc[ai][1][m][1];
                u32x4 w;
                w.x = cvt_pk_bf16(silu_f(g0[0]) * u0[0], silu_f(g0[1]) * u0[1]); w.y = cvt_pk_bf16(silu_f(g0[2]) * u0[2], silu_f(g0[3]) * u0[3]);
                w.z = cvt_pk_bf16(silu_f(g1[0]) * u1[0], silu_f(g1[1]) * u1[1]); w.w = cvt_pk_bf16(silu_f(g1[2]) * u1[2], silu_f(g1[3]) * u1[3]);
                *(u32x4*)rowp = w; }
    }
};
struct EpiResid {
    static constexpr bool PERM = false, AFTER_DRAIN = false;
    XRows X; float scale;
    __device__ __forceinline__ void operator()(const f32x4 (&acc)[2][2][4][2], const Unit& u, int wr, int wc, int fr, int fq) const {
        float* base = X.tile(u.pm) + (size_t)(wr * 64 + fr) * 1024 + u.pn * BM + wc * 32 + 4 * fq;
#pragma unroll
        for (int ai = 0; ai < 2; ++ai)
#pragma unroll
            for (int m = 0; m < 4; ++m) { float* rowp = base + (size_t)(ai * HALF + m * 16) * 1024;
#pragma unroll
                for (int bj = 0; bj < 2; ++bj)
#pragma unroll
                    for (int n = 0; n < 2; ++n) { f32x4* p = (f32x4*)(rowp + bj * HALF + n * 16); const f32x4 o = *p + acc[ai][bj][m][n] * scale; *p = o; } }
    }
};
struct EpiZ {
    static constexpr bool PERM = true, AFTER_DRAIN = false;
    bf16_t* Z; float* G;
    __device__ __forceinline__ void operator()(const f32x4 (&acc)[2][2][4][2], const Unit& u, int wr, int wc, int fr, int fq) const {
        const int row0 = u.pm * BM + wr * 64 + fr;
        if (u.pn < 12) {
            const int col0 = u.pn * BM + wc * 32 + 8 * fq;
#pragma unroll
            for (int ai = 0; ai < 2; ++ai)
#pragma unroll
                for (int m = 0; m < 4; ++m) { bf16_t* rowp = Z + (size_t)(row0 + ai * HALF + m * 16) * 3072 + col0;
#pragma unroll
                    for (int bj = 0; bj < 2; ++bj) { const f32x4 v0 = acc[ai][bj][m][0], v1 = acc[ai][bj][m][1];
                        u32x4 w; w.x = cvt_pk_bf16(v0[0], v0[1]); w.y = cvt_pk_bf16(v0[2], v0[3]); w.z = cvt_pk_bf16(v1[0], v1[1]); w.w = cvt_pk_bf16(v1[2], v1[3]);
                        *(u32x4*)(rowp + bj * HALF) = w; } }
        } else if (wc == 0 && fq == 0) {
#pragma unroll
            for (int ai = 0; ai < 2; ++ai)
#pragma unroll
                for (int m = 0; m < 4; ++m) { float* g = G + (size_t)(row0 + ai * HALF + m * 16) * 8;
                    *(f32x4*)g = acc[ai][0][m][0]; *(f32x4*)(g + 4) = acc[ai][0][m][1]; }
        }
    }
};
template <class Epi, class Sched, bool ALIGN_EPI = false, bool SP2 = false>
__device__ __forceinline__ void gemm_phase(PG8_LAS unsigned char* lds, const Gemm g, const Sched& S, const Epi& E, const int tid) {
    const int wid = __builtin_amdgcn_readfirstlane(tid >> 6), lane = tid & 63, wr = wid >> 2, wc = wid & 3, fr = lane & 15, fq = lane >> 4;
    const int K = g.K, nt = K / BK;
    unsigned voffA[2], voffB[2];
#pragma unroll
    for (int i = 0; i < 2; ++i) { int R, C; stage_rc(tid * 16 + i * 8192, R, C); const int Rb = Epi::PERM ? ((R & ~31) + perm32(R & 31)) : R;
        voffA[i] = (unsigned)(R * K + C) * 2u; voffB[i] = (unsigned)(Rb * K + C) * 2u; }
    const size_t kstep = (size_t)(BK * 2);
    const size_t hstep = (size_t)HALF * K * 2;
    const size_t tstep = 2 * hstep;
    const unsigned ldsw = (unsigned)wid * 1024u;
    const int aoff = lds_byte(wr * 64 + fr, fq * 8), boff = lds_byte(wc * 32 + fr, fq * 8);
#define PG8_SA(b, h) (((b) * 2 + (h)) * HTB)
#define PG8_SB(b, h) ((4 + (b) * 2 + (h)) * HTB)
#define PG8_STAGE(bufoff, gbase, voff) do { _Pragma("unroll") for (int _i = 0; _i < 2; ++_i) \
        __builtin_amdgcn_global_load_lds((const unsigned*)((const char*)(gbase) + (voff)[_i]), (PG8_LAS unsigned*)(lds + (bufoff) + ldsw + _i * 8192), 16, 0, 0); } while (0)
#define PG8_LDA(dst, b, h) do { _Pragma("unroll") for (int m = 0; m < 4; ++m) _Pragma("unroll") for (int k = 0; k < 2; ++k) dst[m][k] = *(const PG8_LAS bf16x8*)(lds + PG8_SA(b, h) + aoff + m * 2048 + k * 1024); } while (0)
#define PG8_LDB(dst, b, h) do { _Pragma("unroll") for (int n = 0; n < 2; ++n) _Pragma("unroll") for (int k = 0; k < 2; ++k) dst[n][k] = *(const PG8_LAS bf16x8*)(lds + PG8_SB(b, h) + boff + n * 2048 + k * 1024); } while (0)
#define PG8_MMA(ai, bj, At, Bt) do { __builtin_amdgcn_s_setprio(1); _Pragma("unroll") for (int m = 0; m < 4; ++m) _Pragma("unroll") for (int n = 0; n < 2; ++n) _Pragma("unroll") for (int k = 0; k < 2; ++k) \
        acc[ai][bj][m][n] = __builtin_amdgcn_mfma_f32_16x16x32_bf16(Bt[n][k], At[m][k], acc[ai][bj][m][n], 0, 0, 0); __builtin_amdgcn_s_setprio(0); } while (0)
#define PG8_WAIT_V(n) asm volatile("s_waitcnt vmcnt(" #n ")" ::: "memory")
#define PG8_WAIT_L(n) asm volatile("s_waitcnt lgkmcnt(" #n ")" ::: "memory")
#define PG8_BAR __builtin_amdgcn_s_barrier()
#define PG8_SCHED __builtin_amdgcn_sched_barrier(0)
    Unit cur, nxt; int ui = 0;
    if (!S.next(0, cur)) return;
    f32x4 acc[2][2][4][2];
#pragma unroll
    for (int a = 0; a < 2; ++a)
#pragma unroll
        for (int b = 0; b < 2; ++b)
#pragma unroll
            for (int m = 0; m < 4; ++m)
#pragma unroll
                for (int n = 0; n < 2; ++n) acc[a][b][m][n] = (f32x4){0.f, 0.f, 0.f, 0.f};
    bf16x8 At[4][2], B0[2][2], B1[2][2];
    const char* cA = (const char*)g.A + (size_t)cur.pm * tstep; const char* cB = (const char*)g.Bt + (size_t)cur.pn * tstep;
    S.a_ready(cur);
    if constexpr (SP2) {
        PG8_STAGE(PG8_SB(0, 0), cB, voffB); PG8_STAGE(PG8_SB(0, 1), cB + hstep, voffB); PG8_STAGE(PG8_SA(0, 0), cA, voffA); PG8_STAGE(PG8_SA(0, 1), cA + hstep, voffA);
        if (wr == 1) PG8_BAR;
        PG8_WAIT_V(2); PG8_BAR;
        PG8_STAGE(PG8_SB(1, 0), cB + kstep, voffB); PG8_STAGE(PG8_SA(1, 0), cA + kstep, voffA); PG8_STAGE(PG8_SB(1, 1), cB + hstep + kstep, voffB);
        PG8_WAIT_V(6); PG8_BAR;
    } else {
        PG8_STAGE(PG8_SB(0, 0), cB, voffB); PG8_STAGE(PG8_SA(0, 0), cA, voffA); PG8_STAGE(PG8_SB(0, 1), cB + hstep, voffB); PG8_STAGE(PG8_SA(0, 1), cA + hstep, voffA);
        if (wr == 1) PG8_BAR;
        PG8_WAIT_V(4); PG8_BAR;
        PG8_STAGE(PG8_SB(1, 0), cB + kstep, voffB); PG8_STAGE(PG8_SA(1, 0), cA + kstep, voffA); PG8_STAGE(PG8_SB(1, 1), cB + hstep + kstep, voffB);
        PG8_WAIT_V(6); PG8_BAR;
    }
    for (;;) {
        const bool has_next = S.next(ui + 1, nxt);
        const char* nA = has_next ? (const char*)g.A + (size_t)nxt.pm * tstep : cA; const char* nB = has_next ? (const char*)g.Bt + (size_t)nxt.pn * tstep : cB;
        for (int t = 0; t < nt; t += 2) {
            const bool last = (t == nt - 2);
            const char* a1 = cA + (size_t)(t + 1) * kstep;
            const char* a2 = last ? nA : cA + (size_t)(t + 2) * kstep; const char* b2 = last ? nB : cB + (size_t)(t + 2) * kstep;
            const char* a3 = a2 + kstep; const char* b3 = b2 + kstep;
            if (last && has_next) S.a_ready(nxt);
            if constexpr (SP2) {
            PG8_LDB(B0, 0, 0); PG8_LDB(B1, 0, 1); PG8_SCHED; PG8_LDA(At, 0, 0); PG8_STAGE(PG8_SA(1, 1), a1 + hstep, voffA);
            PG8_WAIT_V(8); PG8_WAIT_L(0); PG8_BAR; PG8_MMA(0, 0, At, B0); PG8_MMA(0, 1, At, B1); PG8_BAR; PG8_SCHED;
            PG8_LDA(At, 0, 1); PG8_STAGE(PG8_SB(0, 0), b2, voffB); PG8_STAGE(PG8_SB(0, 1), b2 + hstep, voffB); PG8_STAGE(PG8_SA(0, 0), a2, voffA);
            PG8_WAIT_V(8); PG8_WAIT_L(0); PG8_BAR; PG8_MMA(1, 0, At, B0); PG8_MMA(1, 1, At, B1); PG8_BAR; PG8_SCHED;
            PG8_LDB(B0, 1, 0); PG8_LDB(B1, 1, 1); PG8_SCHED; PG8_LDA(At, 1, 0); PG8_STAGE(PG8_SA(0, 1), a2 + hstep, voffA);
            PG8_WAIT_V(8); PG8_WAIT_L(0); PG8_BAR; PG8_MMA(0, 0, At, B0); PG8_MMA(0, 1, At, B1); PG8_BAR; PG8_SCHED;
            PG8_LDA(At, 1, 1); PG8_STAGE(PG8_SB(1, 0), b3, voffB); PG8_STAGE(PG8_SB(1, 1), b3 + hstep, voffB); PG8_STAGE(PG8_SA(1, 0), a3, voffA);
            PG8_WAIT_V(8); PG8_WAIT_L(0); PG8_BAR; PG8_MMA(1, 0, At, B0); PG8_MMA(1, 1, At, B1); PG8_BAR; PG8_SCHED;
            } else {
            PG8_LDB(B0, 0, 0); PG8_SCHED; PG8_LDA(At, 0, 0); PG8_STAGE(PG8_SA(1, 1), a1 + hstep, voffA);
            PG8_WAIT_L(8); PG8_BAR; PG8_WAIT_L(0); PG8_MMA(0, 0, At, B0); PG8_BAR; PG8_SCHED;
            PG8_LDB(B1, 0, 1); PG8_STAGE(PG8_SB(0, 0), b2, voffB);
            PG8_BAR; PG8_WAIT_L(0); PG8_MMA(0, 1, At, B1); PG8_BAR;
            PG8_LDA(At, 0, 1); PG8_STAGE(PG8_SA(0, 0), a2, voffA);
            PG8_BAR; PG8_WAIT_L(0); PG8_MMA(1, 0, At, B0); PG8_BAR; PG8_SCHED;
            PG8_STAGE(PG8_SB(0, 1), b2 + hstep, voffB);
            PG8_WAIT_V(6); PG8_BAR; PG8_MMA(1, 1, At, B1); PG8_BAR;
            PG8_LDB(B0, 1, 0); PG8_SCHED; PG8_LDA(At, 1, 0); PG8_STAGE(PG8_SA(0, 1), a2 + hstep, voffA);
            PG8_WAIT_L(8); PG8_BAR; PG8_WAIT_L(0); PG8_MMA(0, 0, At, B0); PG8_BAR; PG8_SCHED;
            PG8_LDB(B1, 1, 1); PG8_STAGE(PG8_SB(1, 0), b3, voffB);
            PG8_BAR; PG8_WAIT_L(0); PG8_MMA(0, 1, At, B1); PG8_BAR;
            PG8_LDA(At, 1, 1); PG8_STAGE(PG8_SA(1, 0), a3, voffA);
            PG8_BAR; PG8_WAIT_L(0); PG8_MMA(1, 0, At, B0); PG8_BAR; PG8_SCHED;
            PG8_STAGE(PG8_SB(1, 1), b3 + hstep, voffB);
            PG8_WAIT_V(6); PG8_BAR; PG8_MMA(1, 1, At, B1); PG8_BAR;
            }
        }
        if constexpr (ALIGN_EPI) { if (wr == 0) PG8_BAR; }
        if constexpr (!Epi::AFTER_DRAIN) { E(acc, cur, wr, wc, fr, fq); S.done(cur); }
        if (!has_next) break;
#pragma unroll
        for (int a = 0; a < 2; ++a)
#pragma unroll
            for (int b = 0; b < 2; ++b)
#pragma unroll
                for (int m = 0; m < 4; ++m)
#pragma unroll
                    for (int n = 0; n < 2; ++n) acc[a][b][m][n] = (f32x4){0.f, 0.f, 0.f, 0.f};
        cur = nxt; cA = nA; cB = nB; ++ui;
        if constexpr (ALIGN_EPI) { if (wr == 1) PG8_BAR; }
    }
    PG8_WAIT_V(0);
    if constexpr (!ALIGN_EPI) { if (wr == 0) PG8_BAR; }
    PG8_BAR;
    if constexpr (Epi::AFTER_DRAIN) { E.fused(acc, cur, wr, wc, fr, fq, lds, wid, lane); S.done(cur); }
#undef PG8_SA
#undef PG8_SB
#undef PG8_STAGE
#undef PG8_LDA
#undef PG8_LDB
#undef PG8_MMA
#undef PG8_WAIT_V
#undef PG8_WAIT_L
#undef PG8_BAR
#undef PG8_SCHED
}
}
#define LAS __attribute__((address_space(3)))
typedef float f32x4 __attribute__((ext_vector_type(4)));
constexpr int XSPLIT_TILE_ROWS = pg8::XSPLIT_TILE * 256;
#define XB_TMO      128
#define XB_XCNT(j)  (256  + 64 * (j))
#define XB_XSUB(j)  (1280 + 64 * (j))
#define XB_XGEN(j)  (2304 + 64 * (j))
#define XB_TOP      3328
#define XB_TOPGEN   3392
#define XCD_BAR_WORDS 3456
#define XB_SPIN_CAP (1u << 18)

__device__ __forceinline__ unsigned xb_ld(unsigned* p)              { return __hip_atomic_load(p, __ATOMIC_RELAXED, __HIP_MEMORY_SCOPE_AGENT); }
__device__ __forceinline__ unsigned xb_add(unsigned* p, unsigned v) { return __hip_atomic_fetch_add(p, v, __ATOMIC_RELAXED, __HIP_MEMORY_SCOPE_AGENT); }
__device__ __forceinline__ unsigned xb_xcc_id() { return (unsigned)__builtin_amdgcn_s_getreg((3 << 11) | 20) & 0xFu; }
#define XB_SPIN(cond, bar) do { unsigned _sp = 0; while (cond) { __builtin_amdgcn_s_sleep(1); \
    if ((++_sp & 255u) == 0u) { if (xb_ld(&(bar)[XB_TMO])) break; if (_sp > XB_SPIN_CAP) { atomicAdd(&(bar)[XB_TMO], 1u); break; } } } } while (0)

struct XcdBarrier {
    unsigned* bar; unsigned x;
    volatile LAS unsigned* st;
};

__device__ __forceinline__ XcdBarrier xcd_barrier_post(unsigned* bar, volatile LAS unsigned* st) {
    XcdBarrier b; b.bar = bar; b.x = xb_xcc_id(); b.st = st;
    if (threadIdx.x == 0) (void)xb_add(&bar[XB_XCNT(b.x)], 1u);
    return b;
}
__device__ __forceinline__ void xcd_barrier_complete(unsigned* bar, unsigned x, unsigned& nloc, unsigned& nx) {
    const unsigned G = gridDim.x * gridDim.y * gridDim.z;
    unsigned sum, cnt, mine, sp = 0u;
    for (;;) {
        sum = 0u; cnt = 0u; mine = 0u;
#pragma unroll
        for (unsigned j = 0; j < 16; ++j) { const unsigned c = xb_ld(&bar[XB_XCNT(j)]); sum += c; cnt += (c > 0u) ? 1u : 0u; mine = (j == x) ? c : mine; }
        if (sum == G) break;
        __builtin_amdgcn_s_sleep(1);
        if ((++sp & 255u) == 0u) { if (xb_ld(&bar[XB_TMO])) break; if (sp > XB_SPIN_CAP) { atomicAdd(&bar[XB_TMO], 1u); break; } }
    }
    nloc = mine > 0u ? mine : 1u; nx = cnt > 0u ? cnt : 1u;
}

__device__ __forceinline__ void xcd_barrier(const XcdBarrier& b) {
    asm volatile("s_waitcnt vmcnt(0)" ::: "memory");
    __syncthreads();
    if (threadIdx.x == 0) {
        unsigned* bar = b.bar;
        __builtin_amdgcn_s_waitcnt(0);
        unsigned nloc = b.st[0], nx = b.st[1];
        if (nloc == 0u) { xcd_barrier_complete(bar, b.x, nloc, nx); b.st[0] = nloc; b.st[1] = nx; }
        const unsigned old = xb_add(&bar[XB_XSUB(b.x)], 1u);
        const unsigned gen = old / nloc;
        if (old + 1u == (gen + 1u) * nloc) {
            __builtin_amdgcn_fence(__ATOMIC_RELEASE, "agent");
            asm volatile("s_waitcnt vmcnt(0)" ::: "memory");
            const unsigned og = xb_add(&bar[XB_TOP], 1u);
            const unsigned tg = og / nx;
            if (og + 1u == (tg + 1u) * nx) xb_add(&bar[XB_TOPGEN], 1u);
            else XB_SPIN(xb_ld(&bar[XB_TOPGEN]) == tg, bar);
            __builtin_amdgcn_fence(__ATOMIC_ACQUIRE, "agent");
            xb_add(&bar[XB_XGEN(b.x)], 1u);
            asm volatile("s_waitcnt vmcnt(0)" ::: "memory");
        } else {
            XB_SPIN(xb_ld(&bar[XB_XGEN(b.x)]) == gen, bar);
            __builtin_amdgcn_fence(__ATOMIC_ACQUIRE, "agent");
            asm volatile("s_waitcnt vmcnt(0)" ::: "memory");
        }
    }
    __syncthreads();
}

constexpr int NWAVES = 8, NTHREADS = 512;
#ifndef MK_ONE_LAUNCH
#define MK_ONE_LAUNCH 1
#endif
constexpr int D = 1024, DFF = 2816, NBATCH = 8, SEQ = 2048, DEC_B = 128, DEC_T = 4, NMETA = 16, NH = 4, DH = 128, DLRU = 512;
constexpr int R_SAMPLE = 16384, R_META = 16896, N_REAL = 16912, MP = 17152;
constexpr int NZ = 3072, NWIN = 3328, NUP = 5632;
constexpr float EPS = 1e-6f;
constexpr size_t O_YP = 0, O_YS = 16777216, O_PC = O_YS + 524288, O_PN = O_PC + 1048576, O_PM = O_PN + 8192, O_PH = O_PM + 64, O_PCONV = O_PH + 8192,
                 O_SC = O_PCONV + 24576, O_SN = O_SC + 16777216, O_SM = O_SN + 131072, O_SH = O_SM + 1024, O_SCONV = O_SH + 131072, O_END = O_SCONV + 393216;
constexpr size_t MiB = 1u << 20;
constexpr size_t WS_CTL = 0, CTL_ZERO_BYTES = 1 * MiB, WS_XTAIL = 1 * MiB, WS_G = 2 * MiB, WS_WB = 3 * MiB;
constexpr size_t LW_U1 = 0, LW_D1 = 11534336, LW_IN = 17301504, LW_O = 24117248, LW_U2 = 26214400, LW_D2 = 37748736, LW_SIZE = 43515904;
constexpr size_t WS_XN = 87 * MiB, WS_MIX = 121 * MiB, WS_HZ = 155 * MiB, WS_END = 256 * MiB;
static_assert(WS_WB + 2 * LW_SIZE <= WS_XN && WS_XN + (size_t)MP * D * 2 <= WS_MIX && WS_MIX + (size_t)MP * D * 2 <= WS_HZ && WS_HZ + (size_t)MP * NZ * 2 <= WS_END && (size_t)MP * DFF * 2 <= (size_t)MP * NZ * 2, "d_ws map");
constexpr int CW_BAR = 4096;
constexpr int RING_BYTES = 131072, LDSCTL_OFF = 143360, MISC_OFF = LDSCTL_OFF + 320, LDS_BYTES = 147456;

typedef unsigned short bf16;
typedef unsigned v4u __attribute__((ext_vector_type(4)));
typedef unsigned v2u __attribute__((ext_vector_type(2)));
#define LDS_WAIT() asm volatile("s_waitcnt lgkmcnt(0)" ::: "memory")
__device__ __forceinline__ unsigned f2bf(float f) { unsigned u = __builtin_bit_cast(unsigned, f); return (u + 0x7fffu + ((u >> 16) & 1u)) >> 16; }
__device__ __forceinline__ unsigned pk2(float lo, float hi) { return f2bf(lo) | (f2bf(hi) << 16); }
__device__ __forceinline__ float bf2f(bf16 v) { return __builtin_bit_cast(float, (unsigned)v << 16); }
__device__ __forceinline__ float wave_sum(float v) {
#pragma unroll
    for (int o = 1; o < 64; o <<= 1) v += __shfl_xor(v, o);
    return v;
}
__device__ __forceinline__ float sigmoid_f(float x) { return 1.0f / (1.0f + expf(-x)); }
__device__ __forceinline__ float softplus_f(float x) { return fmaxf(x, 0.f) + log1pf(expf(-fabsf(x))); }
__device__ __forceinline__ float gelu_tanh_f(float x) { const float u = 0.7978845608028654f * (x + 0.044715f * x * x * x); return 0.5f * x * (1.0f + tanhf(u)); }

struct Args { const float* in[30]; float* out; unsigned char* ws; int ph_lo, ph_hi, li, pad; };
struct Ctx { volatile LAS unsigned* tab; float* out; unsigned char* ws; };
__device__ __forceinline__ const float* inp(const Ctx& a, int i) { const unsigned lo = __builtin_amdgcn_readfirstlane(a.tab[2 * i]), hi = __builtin_amdgcn_readfirstlane(a.tab[2 * i + 1]); return (const float*)(((unsigned long long)hi << 32) | lo); }
enum { I_XP = 0, I_XS, I_SC, I_SN, I_SM, I_SH, I_SCONV, I_META, I_GFF1, I_W1G, I_W1U, I_W1D, I_GMIX, I_WIN, I_BG, I_CW, I_CB, I_WRA, I_BRA, I_WRX, I_BRX, I_LAM, I_GMO, I_GLO, I_WOUT, I_GFF2, I_W2G, I_W2U, I_W2D, I_GFIN };

__device__ __forceinline__ float* xrow_ptr(const Ctx& a, int r) { return r < XSPLIT_TILE_ROWS ? a.out + (size_t)r * D : (float*)(a.ws + WS_XTAIL) + (size_t)(r - XSPLIT_TILE_ROWS) * D; }

__device__ __forceinline__ void conv_item(const float* W, int K, int Nsrc, int sc0, int nvalid, const float* gamma, float rs, bf16* WT, int n0, int k0, LAS float* scr, int lane) {
#pragma unroll 8
    for (int i = 0; i < 32; ++i) { const int kk = 2 * i + (lane >> 5), j = lane & 31; float v = 0.f;
        if (j < nvalid) { v = W[(size_t)(k0 + kk) * Nsrc + sc0 + j] * rs; if (gamma) v *= gamma[k0 + kk]; }
        scr[kk * 33 + j] = v; }
    LDS_WAIT(); asm volatile("" ::: "memory");
    const int c = lane & 7;
#pragma unroll
    for (int j = 0; j < 4; ++j) { const int n = (lane >> 3) + 8 * j; const LAS float* s = scr + (8 * c) * 33 + n;
        v4u o; o.x = pk2(s[0 * 33], s[1 * 33]); o.y = pk2(s[2 * 33], s[3 * 33]); o.z = pk2(s[4 * 33], s[5 * 33]); o.w = pk2(s[6 * 33], s[7 * 33]);
        *(v4u*)(WT + (size_t)(n0 + n) * K + k0 + 8 * c) = o; }
    LDS_WAIT(); asm volatile("" ::: "memory");
}
constexpr int IT_U = 16 * 176, IT_D = 44 * 32, IT_IN = 16 * 104, IT_O = 16 * 32, IT_LAYER = 2 * IT_U + 2 * IT_D + IT_IN + IT_O;
__device__ __forceinline__ void conv_dispatch(const Ctx& a, int it, LAS float* scr, int lane) {
    const int l = it / IT_LAYER; int r = it % IT_LAYER;
    unsigned char* wb = a.ws + WS_WB + (size_t)l * LW_SIZE;
    if (r < 2 * IT_U) {
        const int second = r >= IT_U; if (second) r -= IT_U;
        const int nb = r % 176, kb = r / 176, n0 = nb * 32, grp = n0 >> 8, w = n0 & 255;
        const float* src = inp(a, second ? (w < 128 ? I_W2G : I_W2U) : (w < 128 ? I_W1G : I_W1U)) + (size_t)l * D * DFF;
        conv_item(src, D, DFF, grp * 128 + (w & 127), 32, inp(a, second ? I_GFF2 : I_GFF1) + l * D, 1.f, (bf16*)(wb + (second ? LW_U2 : LW_U1)), n0, kb * 64, scr, lane);
        return; }
    r -= 2 * IT_U;
    if (r < 2 * IT_D) {
        const int second = r >= IT_D; if (second) r -= IT_D;
        const int nb = r % 32, kb = r / 32;
        conv_item(inp(a, second ? I_W2D : I_W1D) + (size_t)l * DFF * D, DFF, D, nb * 32, 32, nullptr, 1.f, (bf16*)(wb + (second ? LW_D2 : LW_D1)), nb * 32, kb * 64, scr, lane);
        return; }
    r -= 2 * IT_D;
    if (r < IT_IN) {
        const int nb = r % 104, kb = r / 104, n0 = nb * 32; int sc0, nvalid = 32; float rs = 1.f;
        if (n0 < 2048) { sc0 = n0; if (n0 >= 512 && n0 < 1024) rs = 0.08838834764831845f; }
        else if (n0 < 3072) sc0 = n0 + 8;
        else if (n0 == 3072) { sc0 = 2048; nvalid = 8; }
        else { sc0 = 0; nvalid = 0; }
        conv_item(inp(a, I_WIN) + (size_t)l * D * 3080, D, 3080, sc0, nvalid, inp(a, I_GMIX) + l * D, rs, (bf16*)(wb + LW_IN), n0, kb * 64, scr, lane);
        return; }
    r -= IT_IN;
    { const int nb = r % 32, kb = r / 32;
      conv_item(inp(a, I_WOUT) + (size_t)l * D * D, D, D, nb * 32, 32, nullptr, 1.f, (bf16*)(wb + LW_O), nb * 32, kb * 64, scr, lane); }
}
__device__ __forceinline__ void norm_row_to_bf16(const float* xrow, bf16* orow, int lane) {
    const f32x4* xr = (const f32x4*)xrow + lane; f32x4 v[4]; float s = 0.f;
#pragma unroll
    for (int j = 0; j < 4; ++j) { v[j] = xr[64 * j]; s += (v[j].x * v[j].x + v[j].y * v[j].y) + (v[j].z * v[j].z + v[j].w * v[j].w); }
    const float rstd = 1.f / sqrtf(wave_sum(s) * (1.f / D) + EPS);
    unsigned long long* o8 = (unsigned long long*)orow + lane;
#pragma unroll
    for (int j = 0; j < 4; ++j) o8[64 * j] = (unsigned long long)pk2(v[j].x * rstd, v[j].y * rstd) | ((unsigned long long)pk2(v[j].z * rstd, v[j].w * rstd) << 32);
}

__device__ __forceinline__ void mlstm_naive_item(const Ctx& a, int l, int item, LAS float* sm, int tid) {
    const int lane = tid & 63, wave = tid >> 6, e = tid >> 2, qd = tid & 3, d0 = 32 * qd;
    const bool prompt = item < 32; const int b = prompt ? item >> 2 : (item - 32) >> 2, h = prompt ? item & 3 : (item - 32) & 3;
    const bf16* Z = (const bf16*)(a.ws + WS_HZ); const float* G = (const float*)(a.ws + WS_G); bf16* MIX = (bf16*)(a.ws + WS_MIX);
    LAS float* qs = sm; LAS float* ks = sm + 128; LAS float* red = sm + 256; LAS float* red2 = sm + 264;
    float C[32]; float nreg = 0.f, m = 0.f;
#pragma unroll
    for (int j = 0; j < 32; ++j) C[j] = 0.f;
    if (!prompt) {
        const float* C0 = inp(a, I_SC) + ((size_t)(l * DEC_B + b) * NH + h) * DH * DH + (size_t)e * DH + d0;
#pragma unroll
        for (int j = 0; j < 32; ++j) C[j] = C0[j];
        if (tid < 128) nreg = inp(a, I_SN)[((size_t)(l * DEC_B + b) * NH + h) * DH + tid];
        m = inp(a, I_SM)[(l * DEC_B + b) * NH + h];
    }
    const float big = inp(a, I_BG)[l * 8 + h], bfg = inp(a, I_BG)[l * 8 + 4 + h];
    const float gm = inp(a, I_GMO)[l * 512 + h * DH + e];
    const int nsteps = prompt ? NMETA + SEQ : DEC_T;
    for (int t = 0; t < nsteps; ++t) {
        const int row = prompt ? (t < NMETA ? R_META + t : b * SEQ + (t - NMETA)) : R_SAMPLE + b * DEC_T + t;
        const bf16* zr = Z + (size_t)row * NZ;
        if (tid < 128) { qs[tid] = bf2f(zr[h * DH + tid]); ks[tid] = bf2f(zr[512 + h * DH + tid]); }
        const float ve = bf2f(zr[1024 + h * DH + e]), oe = bf2f(zr[1536 + h * DH + e]);
        const float ig = G[(size_t)row * 8 + h] + big, fg = G[(size_t)row * 8 + 4 + h] + bfg;
        const float logf = -softplus_f(-fg);
        const float mn = fmaxf(logf + m, ig), decay = expf(logf + m - mn), igw = expf(ig - mn);
        m = mn;
        __syncthreads();
        float num = 0.f; const float iv = igw * ve;
#pragma unroll
        for (int j = 0; j < 32; ++j) { C[j] = decay * C[j] + iv * ks[d0 + j]; num += C[j] * qs[d0 + j]; }
        num += __shfl_xor(num, 1); num += __shfl_xor(num, 2);
        float pd = 0.f;
        if (tid < 128) { nreg = decay * nreg + igw * ks[tid]; pd = nreg * qs[tid]; }
        if (wave < 2) { pd = wave_sum(pd); if (lane == 0) red[wave] = pd; }
        __syncthreads();
        const float den = red[0] + red[1];
        const float hv = num / fmaxf(fabsf(den), expf(-mn));
        float sq = (qd == 0) ? hv * hv : 0.f; sq = wave_sum(sq); if (lane == 0) red2[wave] = sq;
        __syncthreads();
        float ss = 0.f;
#pragma unroll
        for (int w = 0; w < 8; ++w) ss += red2[w];
        if (qd == 0 && (!prompt || t >= NMETA || b == 0)) {
            const float y = hv * (1.0f / sqrtf(ss * (1.f / DH) + EPS)) * gm * sigmoid_f(oe);
            MIX[(size_t)row * D + h * DH + e] = (bf16)f2bf(y);
        }
    }
    float* oC = a.out + (prompt ? O_PC + ((size_t)(l * NBATCH + b) * NH + h) * DH * DH : O_SC + ((size_t)(l * DEC_B + b) * NH + h) * DH * DH) + (size_t)e * DH + d0;
#pragma unroll
    for (int j = 0; j < 32; ++j) oC[j] = C[j];
    if (tid < 128) a.out[(prompt ? O_PN + ((size_t)(l * NBATCH + b) * NH + h) * DH : O_SN + ((size_t)(l * DEC_B + b) * NH + h) * DH) + tid] = nreg;
    if (tid == 0) a.out[prompt ? O_PM + (l * NBATCH + b) * NH + h : O_SM + (l * DEC_B + b) * NH + h] = m;
    __syncthreads();
}
__device__ __forceinline__ void lru_naive_item(const Ctx& a, int l, int item, LAS float* sm, int tid) {
    const int lane = tid & 63, wave = tid >> 6, c = tid;
    const bool prompt = item < 8; const int b = prompt ? item : item - 8;
    const bf16* Z = (const bf16*)(a.ws + WS_HZ); bf16* MIX = (bf16*)(a.ws + WS_MIX);
    LAS float* red = sm + 33024;
    LAS float* wxs = sm + wave * 4096 + lane;
    float wa[64];
    { const float* pa = inp(a, I_WRA) + (size_t)(l * 8 + wave) * 4096 + lane; const float* px = inp(a, I_WRX) + (size_t)(l * 8 + wave) * 4096 + lane;
#pragma unroll
      for (int d = 0; d < 64; ++d) { wa[d] = pa[d * 64]; wxs[d * 64] = px[d * 64]; } }
    const float cw0 = inp(a, I_CW)[(l * 4 + 0) * 512 + c], cw1 = inp(a, I_CW)[(l * 4 + 1) * 512 + c], cw2 = inp(a, I_CW)[(l * 4 + 2) * 512 + c], cw3 = inp(a, I_CW)[(l * 4 + 3) * 512 + c];
    const float cb = inp(a, I_CB)[l * 512 + c], ba = inp(a, I_BRA)[l * 512 + c], bx = inp(a, I_BRX)[l * 512 + c];
    const float sp = 8.0f * softplus_f(-inp(a, I_LAM)[l * 512 + c]), gl = inp(a, I_GLO)[l * 512 + c];
    float x3 = 0.f, x2 = 0.f, x1 = 0.f, hst = 0.f;
    if (!prompt) { const float* cs = inp(a, I_SCONV) + (size_t)(l * DEC_B + b) * 3 * 512; x3 = cs[c]; x2 = cs[512 + c]; x1 = cs[1024 + c]; hst = inp(a, I_SH)[(size_t)(l * DEC_B + b) * 512 + c]; }
    const int nsteps = prompt ? NMETA + SEQ : DEC_T;
    for (int t = 0; t < nsteps; ++t) {
        const int row = prompt ? (t < NMETA ? R_META + t : b * SEQ + (t - NMETA)) : R_SAMPLE + b * DEC_T + t;
        const bf16* zr = Z + (size_t)row * NZ;
        const float x0 = bf2f(zr[2048 + c]), yg = bf2f(zr[2560 + c]);
        const float xc = cb + x3 * cw0 + x2 * cw1 + x1 * cw2 + x0 * cw3;
        float ra = ba, ri = bx;
#pragma unroll
        for (int d = 0; d < 64; ++d) { const float xd = __builtin_bit_cast(float, __builtin_amdgcn_readlane(__builtin_bit_cast(int, xc), d)); ra += xd * wa[d]; ri += xd * wxs[d * 64]; }
        const float r = sigmoid_f(ra), ig = sigmoid_f(ri);
        const float log_a = -sp * r, av = expf(log_a), bin = sqrtf(-expm1f(2.0f * log_a)) * (ig * xc);
        hst = av * hst + bin;
        float sq = wave_sum(hst * hst); LAS float* rp = red + (t & 1) * 8; if (lane == 0) rp[wave] = sq;
        __syncthreads();
        float ss = 0.f;
#pragma unroll
        for (int w = 0; w < 8; ++w) ss += rp[w];
        if (!prompt || t >= NMETA || b == 0) {
            const float y = hst * (1.0f / sqrtf(ss * (1.f / 512.f) + EPS)) * gl * gelu_tanh_f(yg);
            MIX[(size_t)row * D + 512 + c] = (bf16)f2bf(y);
        }
        x3 = x2; x2 = x1; x1 = x0;
    }
    if (prompt) { a.out[O_PH + (size_t)(l * NBATCH + b) * 512 + c] = hst; float* pc = a.out + O_PCONV + (size_t)(l * NBATCH + b) * 3 * 512; pc[c] = x3; pc[512 + c] = x2; pc[1024 + c] = x1; }
    else { a.out[O_SH + (size_t)(l * DEC_B + b) * 512 + c] = hst; float* pc = a.out + O_SCONV + (size_t)(l * DEC_B + b) * 3 * 512; pc[c] = x3; pc[512 + c] = x2; pc[1024 + c] = x1; }
    __syncthreads();
}


constexpr size_t AG_LA = 0, AG_LH = 1 * MiB, AG_DC = 2 * MiB, AG_DN = AG_DC + (size_t)260 * 65536, AG_SC = AG_DN + (size_t)260 * 512, AG_END = AG_SC + 260 * 8;
static_assert(AG_END <= (size_t)MP * D * 2 && (size_t)257 * 512 * 4 <= MiB, "aggregate scratch fits the XN region");
typedef short bf16x8_t __attribute__((ext_vector_type(8)));
typedef short bf16x4_t __attribute__((ext_vector_type(4)));
constexpr int LRU_UNITS = 257;

template <int MODE>
__device__ __forceinline__ void lru_unit(const Ctx& a, int l, int unit, LAS unsigned char* lds, int tid) {
    const int lane = tid & 63, w = __builtin_amdgcn_readfirstlane(tid >> 6), fr = lane & 15, g = lane >> 4;
    const bool meta = unit == 0; const int b = meta ? 0 : (unit - 1) >> 5, c = meta ? 0 : (unit - 1) & 31;
    const int row0 = meta ? R_META : b * SEQ + c * 64, nvalid = meta ? NMETA : 64;
    const bf16* Z = (const bf16*)(a.ws + WS_HZ); bf16* MIX = (bf16*)(a.ws + WS_MIX);
    float* LA = (float*)(a.ws + WS_XN + AG_LA); float* LH = (float*)(a.ws + WS_XN + AG_LH);
    LAS bf16* xcS = (LAS bf16*)(lds + w * 4608);
    LAS float* ssS = (LAS float*)(lds + 36864);
    const int chg = 64 * w + lane;
    const float cw0 = inp(a, I_CW)[(l * 4 + 0) * 512 + chg], cw1 = inp(a, I_CW)[(l * 4 + 1) * 512 + chg], cw2 = inp(a, I_CW)[(l * 4 + 2) * 512 + chg], cw3 = inp(a, I_CW)[(l * 4 + 3) * 512 + chg];
    const float cb = inp(a, I_CB)[l * 512 + chg];
    float ba[4], bx[4], sp[4], gl[4];
#pragma unroll
    for (int n = 0; n < 4; ++n) { const int cd = 64 * w + 16 * n + fr; ba[n] = inp(a, I_BRA)[l * 512 + cd]; bx[n] = inp(a, I_BRX)[l * 512 + cd];
        sp[n] = 8.0f * softplus_f(-inp(a, I_LAM)[l * 512 + cd]); gl[n] = inp(a, I_GLO)[l * 512 + cd]; }
    bf16x8_t wfA[4][2], wfX[4][2];
    { const float* pa = inp(a, I_WRA) + (size_t)(l * 8 + w) * 4096; const float* px = inp(a, I_WRX) + (size_t)(l * 8 + w) * 4096;
#pragma unroll
      for (int n = 0; n < 4; ++n)
#pragma unroll
        for (int kk = 0; kk < 2; ++kk)
#pragma unroll
            for (int j = 0; j < 8; ++j) { const int d = 32 * kk + 8 * g + j, e = 16 * n + fr; wfA[n][kk][j] = (short)f2bf(pa[d * 64 + e]); wfX[n][kk][j] = (short)f2bf(px[d * 64 + e]); } }
    float x3 = 0.f, x2 = 0.f, x1 = 0.f;
    if (!meta) { const int p3 = c == 0 ? R_META + 13 : row0 - 3;
        x3 = bf2f(Z[(size_t)p3 * NZ + 2048 + chg]); x2 = bf2f(Z[(size_t)(p3 + 1) * NZ + 2048 + chg]); x1 = bf2f(Z[(size_t)(p3 + 2) * NZ + 2048 + chg]); }
    float hin[4] = {0.f, 0.f, 0.f, 0.f}, Atot[4] = {1.f, 1.f, 1.f, 1.f};
    if (MODE == 1 && !meta) {
#pragma unroll
        for (int n = 0; n < 4; ++n) { const int cd = 64 * w + 16 * n + fr; float h = LH[cd];
            for (int cc = 0; cc < c; ++cc) { const int u = 1 + b * 32 + cc; h = LA[(size_t)u * 512 + cd] * h + LH[(size_t)u * 512 + cd]; }
            hin[n] = h; }
    }
    const int nhalf = meta ? 1 : 2;
    for (int hh = 0; hh < nhalf; ++hh) {
        for (int tt = 0; tt < 32; ++tt) { const int tok = 32 * hh + tt; float x0 = 0.f;
            if (tok < nvalid) x0 = bf2f(Z[(size_t)(row0 + tok) * NZ + 2048 + chg]);
            const float xc = cb + x3 * cw0 + x2 * cw1 + x1 * cw2 + x0 * cw3;
            xcS[tt * 72 + lane] = (bf16)f2bf(xc);
            if (tok < nvalid) { x3 = x2; x2 = x1; x1 = x0; } }
        LDS_WAIT(); asm volatile("" ::: "memory");
#pragma unroll 1
        for (int m = 0; m < 2; ++m) {
            float hval[4][4];
            f32x4 accR[4], accI[4];
#pragma unroll
            for (int n = 0; n < 4; ++n) { accR[n] = (f32x4){0.f, 0.f, 0.f, 0.f}; accI[n] = (f32x4){0.f, 0.f, 0.f, 0.f}; }
#pragma unroll
            for (int kk = 0; kk < 2; ++kk) { const bf16x8_t af = *(const LAS bf16x8_t*)(xcS + (16 * m + fr) * 72 + 32 * kk + 8 * g);
#pragma unroll
                for (int n = 0; n < 4; ++n) { accR[n] = __builtin_amdgcn_mfma_f32_16x16x32_bf16(af, wfA[n][kk], accR[n], 0, 0, 0); accI[n] = __builtin_amdgcn_mfma_f32_16x16x32_bf16(af, wfX[n][kk], accI[n], 0, 0, 0); } }
#pragma unroll
            for (int n = 0; n < 4; ++n) {
                float av[4], bv[4];
#pragma unroll
                for (int i = 0; i < 4; ++i) { const int tt = 16 * m + 4 * g + i, tok = 32 * hh + tt;
                    const float r = sigmoid_f(accR[n][i] + ba[n]), ig = sigmoid_f(accI[n][i] + bx[n]);
                    const float log_a = -sp[n] * r, xcv = bf2f(xcS[tt * 72 + 16 * n + fr]);
                    const bool valid = tok < nvalid;
                    av[i] = valid ? expf(log_a) : 1.f; bv[i] = valid ? sqrtf(-expm1f(2.0f * log_a)) * (ig * xcv) : 0.f; }
                float Al = av[0], Hl = bv[0];
#pragma unroll
                for (int i = 1; i < 4; ++i) { Hl = av[i] * Hl + bv[i]; Al *= av[i]; }
                const float A1 = __shfl_xor(Al, 16), H1 = __shfl_xor(Hl, 16);
                const bool odd = g & 1;
                const float Apair = Al * A1, Hpair = odd ? (Al * H1 + Hl) : (A1 * Hl + H1);
                const float Awin = odd ? A1 : 1.f, Hwin = odd ? H1 : 0.f;
                const float A2 = __shfl_xor(Apair, 32), H2 = __shfl_xor(Hpair, 32);
                const bool hi = g & 2;
                const float Apre = hi ? A2 * Awin : Awin, Hpre = hi ? (Awin * H2 + Hwin) : Hwin;
                const float At = Apair * A2, Ht = hi ? (Apair * H2 + Hpair) : (A2 * Hpair + H2);
                if (MODE == 1) { float hs = Apre * hin[n] + Hpre;
#pragma unroll
                    for (int i = 0; i < 4; ++i) { hs = av[i] * hs + bv[i]; hval[n][i] = hs; } }
                hin[n] = At * hin[n] + Ht; Atot[n] *= At;
            }
            if (MODE == 1) {
#pragma unroll
                for (int i = 0; i < 4; ++i) { float s = 0.f;
#pragma unroll
                    for (int n = 0; n < 4; ++n) s += hval[n][i] * hval[n][i];
                    s += __shfl_xor(s, 1); s += __shfl_xor(s, 2); s += __shfl_xor(s, 4); s += __shfl_xor(s, 8);
                    if (fr == 0) ssS[(m * 8 + w) * 32 + 4 * g + i] = s; }
                __syncthreads();
#pragma unroll
                for (int i = 0; i < 4; ++i) { const int tt = 16 * m + 4 * g + i, tok = 32 * hh + tt; float ss = 0.f;
#pragma unroll
                    for (int ww = 0; ww < 8; ++ww) ss += ssS[(m * 8 + ww) * 32 + 4 * g + i];
                    const float inv = 1.0f / sqrtf(ss * (1.f / 512.f) + EPS);
                    if (tok < nvalid) { const unsigned row = (unsigned)(row0 + tok);
#pragma unroll
                        for (int n = 0; n < 4; ++n) { const unsigned cd = 64 * w + 16 * n + fr; const float yg = bf2f(Z[row * NZ + 2560 + cd]);
                            MIX[row * D + 512 + cd] = (bf16)f2bf(hval[n][i] * inv * gl[n] * gelu_tanh_f(yg)); } } }
            }
        }
        asm volatile("" ::: "memory");
    }
    if (MODE == 0) { if (g == 0) {
#pragma unroll
        for (int n = 0; n < 4; ++n) { const int cd = 64 * w + 16 * n + fr; LA[(size_t)unit * 512 + cd] = Atot[n]; LH[(size_t)unit * 512 + cd] = hin[n]; } } }
    else if (!meta && c == 31) {
        if (g == 0) {
#pragma unroll
            for (int n = 0; n < 4; ++n) a.out[O_PH + (size_t)(l * NBATCH + b) * 512 + 64 * w + 16 * n + fr] = hin[n]; }
        float* pc = a.out + O_PCONV + (size_t)(l * NBATCH + b) * 3 * 512; pc[chg] = x3; pc[512 + chg] = x2; pc[1024 + chg] = x1;
    }
    __syncthreads();
}

constexpr int ML_UNITS = 260;
constexpr int TS = 264;
constexpr int CS = 136;
#define NEG_INF (-__builtin_inff())

__device__ __forceinline__ void gates_scan(const float* G, int row0, int nvalid, int h, float big, float bfg, LAS float* bS, LAS float* uS, LAS float* gS, int lane) {
    float cs[4], ig[4];
#pragma unroll
    for (int i = 0; i < 4; ++i) { const int tok = 4 * lane + i; const bool valid = tok < nvalid; const float* gr = G + (size_t)(row0 + tok) * 8;
        const float gi = gr[h] + big, gf = gr[4 + h] + bfg; ig[i] = valid ? gi : NEG_INF; cs[i] = valid ? -softplus_f(-gf) : 0.f; }
    cs[1] += cs[0]; cs[2] += cs[1]; cs[3] += cs[2];
    float incl = cs[3];
#pragma unroll
    for (int off = 1; off < 64; off <<= 1) { const float t = __shfl_up(incl, off); if (lane >= off) incl += t; }
    const float excl = incl - cs[3];
    float u[4], r[4];
#pragma unroll
    for (int i = 0; i < 4; ++i) { cs[i] += excl; u[i] = ig[i] - cs[i]; }
    r[0] = u[0]; r[1] = fmaxf(r[0], u[1]); r[2] = fmaxf(r[1], u[2]); r[3] = fmaxf(r[2], u[3]);
    float imax = r[3];
#pragma unroll
    for (int off = 1; off < 64; off <<= 1) { const float t = __shfl_up(imax, off); if (lane >= off) imax = fmaxf(imax, t); }
    float pre = __shfl_up(imax, 1); if (lane == 0) pre = NEG_INF;
#pragma unroll
    for (int i = 0; i < 4; ++i) { bS[4 * lane + i] = cs[i]; uS[4 * lane + i] = u[i]; gS[4 * lane + i] = fmaxf(pre, r[i]); }
}
template <bool SCALE>
__device__ __forceinline__ void stage_T(const bf16* Zc, int row0, LAS bf16* T, const LAS float* wS, int w, int lane) {
    const int s = 64 * (w & 3) + lane, chalf = 64 * (w >> 2);
    const float ws = SCALE ? wS[s] : 1.f;
    const bf16* src = Zc + (size_t)(row0 + s) * NZ + chalf;
#pragma unroll
    for (int ch = 0; ch < 8; ++ch) { const v4u raw = *(const v4u*)(src + 8 * ch);
#pragma unroll
        for (int j = 0; j < 8; ++j) { unsigned v = (raw[j >> 1] >> (16 * (j & 1))) & 0xffffu;
            if (SCALE) v = f2bf(__builtin_bit_cast(float, v << 16) * ws);
            T[(chalf + 8 * ch + j) * TS + s] = (bf16)v; } }
}

template <int MODE>
__device__ __forceinline__ void mlstm_unit(const Ctx& a, int l, int unit, LAS unsigned char* lds, int tid) {
    const int lane = tid & 63, w = __builtin_amdgcn_readfirstlane(tid >> 6), fr = lane & 15, g = lane >> 4;
    const bool meta = unit < 4; const int bh = meta ? 0 : (unit - 4) >> 3, c = meta ? 0 : (unit - 4) & 7, b = bh >> 2, h = meta ? unit : bh & 3;
    const int row0 = meta ? R_META : b * SEQ + c * 256, nvalid = meta ? NMETA : 256;
    const bf16* Z = (const bf16*)(a.ws + WS_HZ); const float* G = (const float*)(a.ws + WS_G); bf16* MIX = (bf16*)(a.ws + WS_MIX);
    float* DC = (float*)(a.ws + WS_XN + AG_DC); float* DN = (float*)(a.ws + WS_XN + AG_DN); float* SC = (float*)(a.ws + WS_XN + AG_SC);
    LAS bf16* VT = (LAS bf16*)lds;
    LAS bf16* KT = (LAS bf16*)(lds + 128 * TS * 2);
    LAS bf16* C0 = (LAS bf16*)(lds + 144 * TS * 2);
    LAS float* bS = (LAS float*)(lds + 139264); LAS float* uS = bS + 256; LAS float* gS = bS + 512; LAS float* wS = bS + 768;
    if (w == 0) gates_scan(G, row0, nvalid, h, inp(a, I_BG)[l * 8 + h], inp(a, I_BG)[l * 8 + 4 + h], bS, uS, gS, lane);
    if (MODE == 0) {
        __syncthreads();
        const float umax = gS[255], Btot = bS[255];
        if (tid < 256) wS[tid] = expf(uS[tid] - umax);
        __syncthreads();
        stage_T<true>(Z + 1024 + h * DH, row0, VT, wS, w, lane);
        stage_T<false>(Z + 512 + h * DH, row0, KT, wS, w, lane);
        __syncthreads();
        f32x4 acc[8];
#pragma unroll
        for (int n = 0; n < 8; ++n) acc[n] = (f32x4){0.f, 0.f, 0.f, 0.f};
#pragma unroll 2
        for (int kk = 0; kk < 8; ++kk) { const bf16x8_t af = *(const LAS bf16x8_t*)(VT + (16 * w + fr) * TS + 32 * kk + 8 * g);
#pragma unroll
            for (int n = 0; n < 8; ++n) { const bf16x8_t bf = *(const LAS bf16x8_t*)(KT + (16 * n + fr) * TS + 32 * kk + 8 * g); acc[n] = __builtin_amdgcn_mfma_f32_16x16x32_bf16(af, bf, acc[n], 0, 0, 0); } }
        float* dc = DC + (size_t)unit * 16384;
#pragma unroll
        for (int n = 0; n < 8; ++n)
#pragma unroll
            for (int i = 0; i < 4; ++i) dc[(16 * w + 4 * g + i) * 128 + 16 * n + fr] = acc[n][i];
        if (tid < 128) { float s = 0.f;
            for (int t = 0; t < 256; ++t) s += wS[t] * bf2f(KT[tid * TS + t]);
            DN[(size_t)unit * 128 + tid] = s; }
        if (tid == 0) { SC[unit * 2] = Btot; SC[unit * 2 + 1] = Btot + umax; }
        __syncthreads();
        return;
    }
    const int np = meta ? 0 : 1 + c;
    f32x4 cr[8]; float nr = 0.f, m0 = 0.f;
#pragma unroll
    for (int j = 0; j < 8; ++j) cr[j] = (f32x4){0.f, 0.f, 0.f, 0.f};
    for (int p = 0; p < np; ++p) { const int ua = p == 0 ? h : 4 + bh * 8 + (p - 1);
        const float Bj = SC[ua * 2], mlj = SC[ua * 2 + 1], mn = fmaxf(mlj, Bj + m0), dec = expf(Bj + m0 - mn), inw = expf(mlj - mn); m0 = mn;
        const f32x4* src = (const f32x4*)(DC + (size_t)ua * 16384) + tid;
#pragma unroll
        for (int j = 0; j < 8; ++j) cr[j] = cr[j] * dec + src[512 * j] * inw;
        if (tid < 128) nr = nr * dec + DN[(size_t)ua * 128 + tid] * inw; }
    if (!meta && c == 7) {
        const float Bj = SC[unit * 2], mlj = SC[unit * 2 + 1], mn = fmaxf(mlj, Bj + m0), dec = expf(Bj + m0 - mn), inw = expf(mlj - mn);
        const f32x4* src = (const f32x4*)(DC + (size_t)unit * 16384) + tid; f32x4* dst = (f32x4*)(a.out + O_PC + ((size_t)(l * NBATCH + b) * NH + h) * DH * DH) + tid;
#pragma unroll
        for (int j = 0; j < 8; ++j) dst[512 * j] = cr[j] * dec + src[512 * j] * inw;
        if (tid < 128) a.out[O_PN + ((size_t)(l * NBATCH + b) * NH + h) * DH + tid] = nr * dec + DN[(size_t)unit * 128 + tid] * inw;
        if (tid == 0) a.out[O_PM + (l * NBATCH + b) * NH + h] = mn;
    }
#pragma unroll
    for (int j = 0; j < 8; ++j) { const int idx = 2048 * j + 4 * tid, e = idx >> 7, d = idx & 127; v2u pk; pk.x = pk2(cr[j].x, cr[j].y); pk.y = pk2(cr[j].z, cr[j].w); *(LAS v2u*)(C0 + e * CS + d) = pk; }
    if (tid < 128) C0[128 * CS + tid] = (bf16)f2bf(nr);
    for (int i = tid; i < 15 * CS; i += NTHREADS) C0[129 * CS + i] = 0;
    stage_T<false>(Z + 1024 + h * DH, row0, VT, wS, w, lane);
    for (int i = tid; i < 16 * TS; i += NTHREADS) VT[128 * TS + i] = (i < TS) ? (bf16)0x3F80 : (bf16)0;
    __syncthreads();
    const int hq = h * DH;
    bf16x8_t qf[2][4];
#pragma unroll
    for (int tt = 0; tt < 2; ++tt)
#pragma unroll
        for (int kk = 0; kk < 4; ++kk) qf[tt][kk] = *(const bf16x8_t*)(Z + (size_t)(row0 + 32 * w + 16 * tt + fr) * NZ + hq + 32 * kk + 8 * g);
    float MxT[2];
#pragma unroll
    for (int tt = 0; tt < 2; ++tt) MxT[tt] = fmaxf(gS[32 * w + 16 * tt + fr], m0);
    f32x4 O[2][9];
#pragma unroll
    for (int tt = 0; tt < 2; ++tt)
#pragma unroll
        for (int n = 0; n < 9; ++n) O[tt][n] = (f32x4){0.f, 0.f, 0.f, 0.f};
#pragma unroll
    for (int kk = 0; kk < 4; ++kk)
#pragma unroll
        for (int n = 0; n < 9; ++n) { const bf16x8_t cf = *(const LAS bf16x8_t*)(C0 + (16 * n + fr) * CS + 32 * kk + 8 * g);
#pragma unroll
            for (int tt = 0; tt < 2; ++tt) O[tt][n] = __builtin_amdgcn_mfma_f32_16x16x32_bf16(qf[tt][kk], cf, O[tt][n], 0, 0, 0); }
#pragma unroll
    for (int tt = 0; tt < 2; ++tt)
#pragma unroll
        for (int i = 0; i < 4; ++i) { const float sc = expf(m0 - fmaxf(gS[32 * w + 16 * tt + 4 * g + i], m0));
#pragma unroll
            for (int n = 0; n < 9; ++n) O[tt][n][i] *= sc; }
    for (int kb = 0; kb <= w; ++kb) {
        bf16x8_t pa[2];
#pragma unroll
        for (int st = 0; st < 2; ++st) {
            bf16x8_t kf[4];
#pragma unroll
            for (int kk = 0; kk < 4; ++kk) kf[kk] = *(const bf16x8_t*)(Z + (size_t)(row0 + 32 * kb + 16 * st + fr) * NZ + 512 + hq + 32 * kk + 8 * g);
            const f32x4 us = *(const LAS f32x4*)(uS + 32 * kb + 16 * st + 4 * g);
#pragma unroll
            for (int tt = 0; tt < 2; ++tt) { f32x4 sT = (f32x4){0.f, 0.f, 0.f, 0.f};
#pragma unroll
                for (int kk = 0; kk < 4; ++kk) sT = __builtin_amdgcn_mfma_f32_16x16x32_bf16(kf[kk], qf[tt][kk], sT, 0, 0, 0);
                const int t = 32 * w + 16 * tt + fr;
#pragma unroll
                for (int i = 0; i < 4; ++i) { const int s = 32 * kb + 16 * st + 4 * g + i; const float p = (s <= t) ? sT[i] * expf(us[i] - MxT[tt]) : 0.f; pa[tt][4 * st + i] = (short)f2bf(p); } }
        }
#pragma unroll
        for (int n = 0; n < 9; ++n) { const bf16x4_t lo = *(const LAS bf16x4_t*)(VT + (16 * n + fr) * TS + 32 * kb + 4 * g), hi = *(const LAS bf16x4_t*)(VT + (16 * n + fr) * TS + 32 * kb + 16 + 4 * g);
            const bf16x8_t vf = __builtin_shufflevector(lo, hi, 0, 1, 2, 3, 4, 5, 6, 7);
#pragma unroll
            for (int tt = 0; tt < 2; ++tt) O[tt][n] = __builtin_amdgcn_mfma_f32_16x16x32_bf16(pa[tt], vf, O[tt][n], 0, 0, 0); }
    }
    float gm[8];
#pragma unroll
    for (int n = 0; n < 8; ++n) gm[n] = inp(a, I_GMO)[l * 512 + hq + 16 * n + fr];
#pragma unroll
    for (int tt = 0; tt < 2; ++tt)
#pragma unroll
        for (int i = 0; i < 4; ++i) { const int t = 32 * w + 16 * tt + 4 * g + i;
            const float den = __shfl(O[tt][8][i], lane & 48);
            const float mt = bS[t] + fmaxf(gS[t], m0), rden = 1.0f / fmaxf(fabsf(den), expf(-mt));
            float hv[8], ss = 0.f;
#pragma unroll
            for (int n = 0; n < 8; ++n) { hv[n] = O[tt][n][i] * rden; ss += hv[n] * hv[n]; }
            ss += __shfl_xor(ss, 1); ss += __shfl_xor(ss, 2); ss += __shfl_xor(ss, 4); ss += __shfl_xor(ss, 8);
            const float inv = 1.0f / sqrtf(ss * (1.f / DH) + EPS);
            if (t < nvalid) { const unsigned row = (unsigned)(row0 + t);
#pragma unroll
                for (int n = 0; n < 8; ++n) { const unsigned col = hq + 16 * n + fr; const float og = bf2f(Z[row * NZ + 1536 + col]);
                    MIX[row * D + col] = (bf16)f2bf(hv[n] * inv * gm[n] * sigmoid_f(og)); } } }
    __syncthreads();
}

constexpr int N_PHASES = 23;
constexpr int TAB_OFF = MISC_OFF + 128;
static_assert(TAB_OFF + 256 <= LDS_BYTES, "LDS map");
__global__ void __launch_bounds__(NTHREADS, 2) mega_fwd(Args args) {
    extern __shared__ __attribute__((aligned(16))) unsigned char lds_raw[];
    LAS unsigned char* lds = (LAS unsigned char*)lds_raw;
    volatile LAS unsigned* MISC = (volatile LAS unsigned*)(lds + MISC_OFF);
    const int tid0 = threadIdx.x;
    for (int u = tid0; u < (LDS_BYTES - LDSCTL_OFF) / 4; u += NTHREADS) ((LAS unsigned*)(lds + LDSCTL_OFF))[u] = 0u;
    __syncthreads();
    if (tid0 == 0) {
        volatile LAS unsigned* tab = (volatile LAS unsigned*)(lds + TAB_OFF);
#pragma unroll
        for (int i = 0; i < 30; ++i) { const unsigned long long v = (unsigned long long)args.in[i]; tab[2 * i] = (unsigned)v; tab[2 * i + 1] = (unsigned)(v >> 32); }
    }
    __syncthreads();
    XcdBarrier bar; bar.bar = (unsigned*)(args.ws + WS_CTL) + CW_BAR; bar.x = 0; bar.st = nullptr;
    if ((args.ph_hi - args.ph_lo) > 1) bar = xcd_barrier_post((unsigned*)(args.ws + WS_CTL) + CW_BAR, MISC + 8);

    for (int p = args.ph_lo; p < args.ph_hi; ++p) {
        if (p > args.ph_lo) { XcdBarrier b2 = bar; asm volatile("" : "+s"(b2.bar), "+s"(b2.x)); xcd_barrier(b2); }
        Ctx cx; { unsigned tv = (unsigned)(size_t)(lds + TAB_OFF); asm volatile("" : "+v"(tv)); cx.tab = (volatile LAS unsigned*)(size_t)tv; } cx.out = args.out; cx.ws = args.ws;
        int G = gridDim.x, bx = blockIdx.x, tid = tid0;
        asm volatile("" : "+s"(cx.out), "+s"(cx.ws), "+s"(G), "+s"(bx), "+v"(tid));
        unsigned char* ws = cx.ws;
        const int lane = tid & 63, wave = __builtin_amdgcn_readfirstlane(tid >> 6);
        const int vcu = (G % 8 == 0) ? (bx % 8) * (G / 8) + bx / 8 : bx;
        const int gw = vcu * NWAVES + wave, NGW = G * NWAVES;
        bf16* XN = (bf16*)(ws + WS_XN); bf16* MIX = (bf16*)(ws + WS_MIX); bf16* HZ = (bf16*)(ws + WS_HZ); float* GATES = (float*)(ws + WS_G);
        const pg8::XRows XR{cx.out, (float*)(ws + WS_XTAIL)};
        if (p == 0) {
            LAS float* scr = (LAS float*)(lds + wave * 16384);
            for (int it = gw; it < 2 * IT_LAYER; it += NGW) conv_dispatch(cx, it, scr, lane);
            for (int r = gw; r < MP; r += NGW) {
                float* xo = xrow_ptr(cx, r);
                if (r < N_REAL) {
                    const float* src = r < R_SAMPLE ? inp(cx, I_XP) + (size_t)r * D : (r < R_META ? inp(cx, I_XS) + (size_t)(r - R_SAMPLE) * D : inp(cx, I_META) + (size_t)(r - R_META) * D);
#pragma unroll
                    for (int j = 0; j < 4; ++j) ((f32x4*)xo)[lane + 64 * j] = ((const f32x4*)src)[lane + 64 * j];
                    norm_row_to_bf16(src, XN + (size_t)r * D, lane);
                } else {
#pragma unroll
                    for (int j = 0; j < 4; ++j) ((f32x4*)xo)[lane + 64 * j] = (f32x4){0.f, 0.f, 0.f, 0.f};
                    for (int j = 0; j < 2; ++j) { ((v4u*)(XN + (size_t)r * D))[lane + 64 * j] = (v4u){0u, 0u, 0u, 0u}; ((v4u*)(MIX + (size_t)r * D))[lane + 64 * j] = (v4u){0u, 0u, 0u, 0u}; }
                }
            }
            continue;
        }
        const int l = (p - 1) / 11, k = (p - 1) % 11;
        const unsigned char* wb = ws + WS_WB + (size_t)l * LW_SIZE;
        if (k == 0 || k == 8) {
            pg8::Gemm g{XN, (const bf16*)(wb + (k == 0 ? LW_U1 : LW_U2)), MP, NUP, D}; pg8::StaticOrder S; S.init(MP, NUP, G, bx);
            pg8::EpiSwiGLU E{HZ, DFF};
            pg8::gemm_phase<pg8::EpiSwiGLU, pg8::StaticOrder, true, true>(lds, g, S, E, tid);
        } else if (k == 1 || k == 9) {
            pg8::Gemm g{HZ, (const bf16*)(wb + (k == 1 ? LW_D1 : LW_D2)), MP, D, DFF}; pg8::StaticOrder S; S.init(MP, D, G, bx);
            pg8::EpiResid E{XR, 0.5f};
            pg8::gemm_phase<pg8::EpiResid, pg8::StaticOrder, true, true>(lds, g, S, E, tid);
        } else if (k == 6) {
            pg8::Gemm g{MIX, (const bf16*)(wb + LW_O), MP, D, D}; pg8::StaticOrder S; S.init(MP, D, G, bx);
            pg8::EpiResid E{XR, 1.0f};
            pg8::gemm_phase<pg8::EpiResid, pg8::StaticOrder, true, true>(lds, g, S, E, tid);
        } else if (k == 3) {
            pg8::Gemm g{XN, (const bf16*)(wb + LW_IN), MP, NWIN, D}; pg8::StaticOrder S; S.init(MP, NWIN, G, bx);
            pg8::EpiZ E{HZ, GATES};
            pg8::gemm_phase<pg8::EpiZ, pg8::StaticOrder, true, true>(lds, g, S, E, tid);
        } else if (k == 2 || k == 7 || (k == 10 && l == 0)) {
            for (int r = gw; r < MP; r += NGW) norm_row_to_bf16(xrow_ptr(cx, r), XN + (size_t)r * D, lane);
        } else if (k == 10) {
            const float* gfin = inp(cx, I_GFIN);
            for (int r = gw; r < R_META; r += NGW) {
                f32x4* xr = (f32x4*)xrow_ptr(cx, r) + lane; const f32x4* gf = (const f32x4*)gfin + lane; f32x4 v[4]; float s = 0.f;
#pragma unroll
                for (int j = 0; j < 4; ++j) { v[j] = xr[64 * j]; s += (v[j].x * v[j].x + v[j].y * v[j].y) + (v[j].z * v[j].z + v[j].w * v[j].w); }
                const float rstd = 1.f / sqrtf(wave_sum(s) * (1.f / D) + EPS);
#pragma unroll
                for (int j = 0; j < 4; ++j) xr[64 * j] = v[j] * rstd * gf[64 * j];
            }
        } else if (k == 4) {
            for (int it = vcu; it < ML_UNITS + LRU_UNITS + DEC_B * NH; it += G) {
                int ll = l, t2 = tid; asm volatile("" : "+s"(ll), "+v"(t2));
                if (it < ML_UNITS) mlstm_unit<0>(cx, ll, it, lds, t2);
                else if (it < ML_UNITS + LRU_UNITS) lru_unit<0>(cx, ll, it - ML_UNITS, lds, t2);
                else mlstm_naive_item(cx, ll, 32 + (it - ML_UNITS - LRU_UNITS), (LAS float*)lds, t2);
            }
        } else if (k == 5) {
            for (int it = vcu; it < ML_UNITS + LRU_UNITS + DEC_B; it += G) {
                int ll = l, t2 = tid; asm volatile("" : "+s"(ll), "+v"(t2));
                if (it < ML_UNITS) mlstm_unit<1>(cx, ll, it, lds, t2);
                else if (it < ML_UNITS + LRU_UNITS) lru_unit<1>(cx, ll, it - ML_UNITS, lds, t2);
                else lru_naive_item(cx, ll, 8 + (it - ML_UNITS - LRU_UNITS), (LAS float*)lds, t2);
            }
        }
    }
}

extern "C" void kernel_launch(void* const* d_in, const int* in_sizes, int n_in, void* d_out, int out_size, void* d_ws, size_t ws_size, hipStream_t stream) {
    static int grid = 0;
    if (grid == 0) {
        if (n_in != 30 || out_size != (int)O_END || ws_size < WS_END) { fprintf(stderr, "kernel_launch: unexpected shapes: n_in %d out %d ws %zu\n", n_in, out_size, ws_size); grid = -1; return; }
        int dev = 0, cus = 0, per_cu = 0;
        if (hipGetDevice(&dev) != hipSuccess || hipDeviceGetAttribute(&cus, hipDeviceAttributeMultiprocessorCount, dev) != hipSuccess) { grid = -1; return; }
        if (hipFuncSetAttribute((const void*)mega_fwd, hipFuncAttributeMaxDynamicSharedMemorySize, LDS_BYTES) != hipSuccess) { fprintf(stderr, "kernel_launch: hipFuncSetAttribute failed\n"); grid = -1; return; }
        if (hipOccupancyMaxActiveBlocksPerMultiprocessor(&per_cu, (const void*)mega_fwd, NTHREADS, LDS_BYTES) != hipSuccess || per_cu < 1)
            fprintf(stderr, "kernel_launch: note: occupancy query reports %d workgroups per CU\n", per_cu);
        (void)hipGetLastError();
        grid = cus;
    }
    if (grid < 0) return;
    if (hipMemsetAsync((char*)d_ws + WS_CTL, 0, CTL_ZERO_BYTES, stream) != hipSuccess) { fprintf(stderr, "kernel_launch: hipMemsetAsync failed\n"); return; }
    Args a{};
    for (int i = 0; i < 30; ++i) a.in[i] = (const float*)d_in[i];
    a.out = (float*)d_out; a.ws = (unsigned char*)d_ws;
#if MK_ONE_LAUNCH
    a.ph_lo = 0; a.ph_hi = N_PHASES; a.li = 0;
    hipLaunchKernelGGL(mega_fwd, dim3(grid), dim3(NTHREADS), LDS_BYTES, stream, a);
#else
    for (int p = 0; p < N_PHASES; ++p) { a.ph_lo = p; a.ph_hi = p + 1; a.li = p; hipLaunchKernelGGL(mega_fwd, dim3(grid), dim3(NTHREADS), LDS_BYTES, stream, a); }
#endif
}
```

```cpp
#include <hip/hip_runtime.h>
#include <cstdio>
#include <cstdint>
namespace pg8 {
#define PG8_LAS __attribute__((address_space(3)))
typedef unsigned short bf16_t;
typedef short bf16x8 __attribute__((ext_vector_type(8)));
typedef float f32x4 __attribute__((ext_vector_type(4)));
typedef unsigned u32x4 __attribute__((ext_vector_type(4)));
constexpr int BM = 256, BK = 64, HALF = 128, HTB = HALF * BK * 2  , STAGE_BYTES = 8 * HTB, NXCD = 8, WGM = 8;

__host__ __device__ __forceinline__ int lds_byte(int r, int c) { const int st = (r >> 4) * 2 + (c >> 5), rr = r & 15, cc = c & 31, ob = rr * 64 + cc * 2; return st * 1024 + (ob ^ (((ob >> 9) & 1) << 5)); }
__host__ __device__ __forceinline__ void stage_rc(int b, int& R, int& C) { const int st = b / 1024, sb = b % 1024, swz = sb ^ (((sb >> 9) & 1) << 5); R = (st >> 1) * 16 + swz / 64; C = (st & 1) * 32 + (swz % 64) / 2; }
__host__ __device__ __forceinline__ int perm32(int rho) { const int n = rho >> 4, i = rho & 15; return 8 * (i >> 2) + 4 * n + (i & 3); }

struct Unit { int pm, pn; };
struct Gemm { const bf16_t* A; const bf16_t* Bt; int M, N, K; };

struct StaticOrder {
    int nM, nN, nwg, G, c;
    __host__ __device__ void init(int M, int N, int G_, int c_) { nM = M / BM; nN = N / BM; nwg = nM * nN; G = G_; c = c_; }
    __host__ __device__ bool next(int i, Unit& u) const {
        const long L = (long)i * G + c; if (L >= nwg) return false;
        int wgid = (int)L; { const int q = nwg / NXCD, r = nwg % NXCD, xcd = wgid % NXCD, off = wgid / NXCD; wgid = (xcd < r ? xcd * (q + 1) : r * (q + 1) + (xcd - r) * q) + off; }
        const int nig = WGM * nN, gid = wgid / nig, fm = gid * WGM, gsz = (nM - fm) < WGM ? (nM - fm) : WGM;
        u.pm = fm + ((wgid % nig) % gsz); u.pn = (wgid % nig) / gsz; return true;
    }
    __device__ __forceinline__ void a_ready(const Unit&) const {}
    __device__ __forceinline__ void done(const Unit&) const {}
};


__device__ __forceinline__ unsigned cvt_pk_bf16(float lo, float hi) { unsigned r; asm volatile("v_cvt_pk_bf16_f32 %0, %1, %2" : "=v"(r) : "v"(lo), "v"(hi)); return r; }
__device__ __forceinline__ float silu_f(float g) { return g * __builtin_amdgcn_rcpf(1.0f + __expf(-g)); }

constexpr int XSPLIT_TILE = 66;
struct XRows { float* lo; float* tail; __device__ __forceinline__ float* tile(int pm) const { return pm < XSPLIT_TILE ? lo + (size_t)pm * BM * 1024 : tail + (size_t)(pm - XSPLIT_TILE) * BM * 1024; } };

struct EpiSwiGLU {
    static constexpr bool PERM = true, AFTER_DRAIN = false;
    bf16_t* O; int ldc;
    __device__ __forceinline__ void operator()(const f32x4 (&acc)[2][2][4][2], const Unit& u, int wr, int wc, int fr, int fq) const {
        const int row0 = u.pm * BM + wr * 64 + fr; const int col0 = u.pn * HALF + wc * 32 + 8 * fq;
#pragma unroll
        for (int ai = 0; ai < 2; ++ai)
#pragma unroll
            for (int m = 0; m < 4; ++m) { bf16_t* rowp = O + (size_t)(row0 + ai * HALF + m * 16) * ldc + col0;
                const f32x4 g0 = acc[ai][0][m][0], g1 = acc[ai][0][m][1], u0 = acc[ai][1][m][0], u1 = acc[ai][1][m][1];
                u32x4 w;
                w.x = cvt_pk_bf16(silu_f(g0[0]) * u0[0], silu_f(g0[1]) * u0[1]); w.y = cvt_pk_bf16(silu_f(g0[2]) * u0[2], silu_f(g0[3]) * u0[3]);
                w.z = cvt_pk_bf16(silu_f(g1[0]) * u1[0], silu_f(g1[1]) * u1[1]); w.w = cvt_pk_bf16(silu_f(g1[2]) * u1[2], silu_f(g1[3]) * u1[3]);
                *(u32x4*)rowp = w; }
    }
};
struct EpiResid {
    static constexpr bool PERM = false, AFTER_DRAIN = false;
    XRows X; float scale;
    __device__ __forceinline__ void operator()(const f32x4 (&acc)[2][2][4][2], const Unit& u, int wr, int wc, int fr, int fq) const {
        float* base = X.tile(u.pm) + (size_t)(wr * 64 + fr) * 1024 + u.pn * BM + wc * 32 + 4 * fq;
#pragma unroll
        for (int ai = 0; ai < 2; ++ai)
#pragma unroll
            for (int m = 0; m < 4; ++m) { float* rowp = base + (size_t)(ai * HALF + m * 16) * 1024;
#pragma unroll
                for (int bj = 0; bj < 2; ++bj)
#pragma unroll
                    for (int n = 0; n < 2; ++n) { f32x4* p = (f32x4*)(rowp + bj * HALF + n * 16); const f32x4 o = *p + acc[ai][bj][m][n] * scale; *p = o; } }
    }
};
struct EpiZ {
    static constexpr bool PERM = true, AFTER_DRAIN = false;
    bf16_t* Z; float* G;
    __device__ __forceinline__ void operator()(const f32x4 (&acc)[2][2][4][2], const Unit& u, int wr, int wc, int fr, int fq) const {
        const int row0 = u.pm * BM + wr * 64 + fr;
        if (u.pn < 12) {
            const int col0 = u.pn * BM + wc * 32 + 8 * fq;
#pragma unroll
            for (int ai = 0; ai < 2; ++ai)
#pragma unroll
                for (int m = 0; m < 4; ++m) { bf16_t* rowp = Z + (size_t)(row0 + ai * HALF + m * 16) * 3072 + col0;
#pragma unroll
                    for (int bj = 0; bj < 2; ++bj) { const f32x4 v0 = acc[ai][bj][m][0], v1 = acc[ai][bj][m][1];
                        u32x4 w; w.x = cvt_pk_bf16(v0[0], v0[1]); w.y = cvt_pk_bf16(v0[2], v0[3]); w.z = cvt_pk_bf16(v1[0], v1[1]); w.w = cvt_pk_bf16(v1[2], v1[3]);
                        *(u32x4*)(rowp + bj * HALF) = w; } }
        } else if (wc == 0 && fq == 0) {
#pragma unroll
            for (int ai = 0; ai < 2; ++ai)
#pragma unroll
                for (int m = 0; m < 4; ++m) { float* g = G + (size_t)(row0 + ai * HALF + m * 16) * 8;
                    *(f32x4*)g = acc[ai][0][m][0]; *(f32x4*)(g + 4) = acc[ai][0][m][1]; }
        }
    }
};
template <class Epi, class Sched, bool ALIGN_EPI = false, bool SP2 = false>
__device__ __forceinline__ void gemm_phase(PG8_LAS unsigned char* lds, const Gemm g, const Sched& S, const Epi& E, const int tid) {
    const int wid = __builtin_amdgcn_readfirstlane(tid >> 6), lane = tid & 63, wr = wid >> 2, wc = wid & 3, fr = lane & 15, fq = lane >> 4;
    const int K = g.K, nt = K / BK;
    unsigned voffA[2], voffB[2];
#pragma unroll
    for (int i = 0; i < 2; ++i) { int R, C; stage_rc(tid * 16 + i * 8192, R, C); const int Rb = Epi::PERM ? ((R & ~31) + perm32(R & 31)) : R;
        voffA[i] = (unsigned)(R * K + C) * 2u; voffB[i] = (unsigned)(Rb * K + C) * 2u; }
    const size_t kstep = (size_t)(BK * 2);
    const size_t hstep = (size_t)HALF * K * 2;
    const size_t tstep = 2 * hstep;
    const unsigned ldsw = (unsigned)wid * 1024u;
    const int aoff = lds_byte(wr * 64 + fr, fq * 8), boff = lds_byte(wc * 32 + fr, fq * 8);
#define PG8_SA(b, h) (((b) * 2 + (h)) * HTB)
#define PG8_SB(b, h) ((4 + (b) * 2 + (h)) * HTB)
#define PG8_STAGE(bufoff, gbase, voff) do { _Pragma("unroll") for (int _i = 0; _i < 2; ++_i) \
        __builtin_amdgcn_global_load_lds((const unsigned*)((const char*)(gbase) + (voff)[_i]), (PG8_LAS unsigned*)(lds + (bufoff) + ldsw + _i * 8192), 16, 0, 0); } while (0)
#define PG8_LDA(dst, b, h) do { _Pragma("unroll") for (int m = 0; m < 4; ++m) _Pragma("unroll") for (int k = 0; k < 2; ++k) dst[m][k] = *(const PG8_LAS bf16x8*)(lds + PG8_SA(b, h) + aoff + m * 2048 + k * 1024); } while (0)
#define PG8_LDB(dst, b, h) do { _Pragma("unroll") for (int n = 0; n < 2; ++n) _Pragma("unroll") for (int k = 0; k < 2; ++k) dst[n][k] = *(const PG8_LAS bf16x8*)(lds + PG8_SB(b, h) + boff + n * 2048 + k * 1024); } while (0)
#define PG8_MMA(ai, bj, At, Bt) do { __builtin_amdgcn_s_setprio(1); _Pragma("unroll") for (int m = 0; m < 4; ++m) _Pragma("unroll") for (int n = 0; n < 2; ++n) _Pragma("unroll") for (int k = 0; k < 2; ++k) \
        acc[ai][bj][m][n] = __builtin_amdgcn_mfma_f32_16x16x32_bf16(Bt[n][k], At[m][k], acc[ai][bj][m][n], 0, 0, 0); __builtin_amdgcn_s_setprio(0); } while (0)
#define PG8_WAIT_V(n) asm volatile("s_waitcnt vmcnt(" #n ")" ::: "memory")
#define PG8_WAIT_L(n) asm volatile("s_waitcnt lgkmcnt(" #n ")" ::: "memory")
#define PG8_BAR __builtin_amdgcn_s_barrier()
#define PG8_SCHED __builtin_amdgcn_sched_barrier(0)
    Unit cur, nxt; int ui = 0;
    if (!S.next(0, cur)) return;
    f32x4 acc[2][2][4][2];
#pragma unroll
    for (int a = 0; a < 2; ++a)
#pragma unroll
        for (int b = 0; b < 2; ++b)
#pragma unroll
            for (int m = 0; m < 4; ++m)
#pragma unroll
                for (int n = 0; n < 2; ++n) acc[a][b][m][n] = (f32x4){0.f, 0.f, 0.f, 0.f};
    bf16x8 At[4][2], B0[2][2], B1[2][2];
    const char* cA = (const char*)g.A + (size_t)cur.pm * tstep; const char* cB = (const char*)g.Bt + (size_t)cur.pn * tstep;
    S.a_ready(cur);
    if constexpr (SP2) {
        PG8_STAGE(PG8_SB(0, 0), cB, voffB); PG8_STAGE(PG8_SB(0, 1), cB + hstep, voffB); PG8_STAGE(PG8_SA(0, 0), cA, voffA); PG8_STAGE(PG8_SA(0, 1), cA + hstep, voffA);
        if (wr == 1) PG8_BAR;
        PG8_WAIT_V(2); PG8_BAR;
        PG8_STAGE(PG8_SB(1, 0), cB + kstep, voffB); PG8_STAGE(PG8_SA(1, 0), cA + kstep, voffA); PG8_STAGE(PG8_SB(1, 1), cB + hstep + kstep, voffB);
        PG8_WAIT_V(6); PG8_BAR;
    } else {
        PG8_STAGE(PG8_SB(0, 0), cB, voffB); PG8_STAGE(PG8_SA(0, 0), cA, voffA); PG8_STAGE(PG8_SB(0, 1), cB + hstep, voffB); PG8_STAGE(PG8_SA(0, 1), cA + hstep, voffA);
        if (wr == 1) PG8_BAR;
        PG8_WAIT_V(4); PG8_BAR;
        PG8_STAGE(PG8_SB(1, 0), cB + kstep, voffB); PG8_STAGE(PG8_SA(1, 0), cA + kstep, voffA); PG8_STAGE(PG8_SB(1, 1), cB + hstep + kstep, voffB);
        PG8_WAIT_V(6); PG8_BAR;
    }
    for (;;) {
        const bool has_next = S.next(ui + 1, nxt);
        const char* nA = has_next ? (const char*)g.A + (size_t)nxt.pm * tstep : cA; const char* nB = has_next ? (const char*)g.Bt + (size_t)nxt.pn * tstep : cB;
        for (int t = 0; t < nt; t += 2) {
            const bool last = (t == nt - 2);
            const char* a1 = cA + (size_t)(t + 1) * kstep;
            const char* a2 = last ? nA : cA + (size_t)(t + 2) * kstep; const char* b2 = last ? nB : cB + (size_t)(t + 2) * kstep;
            const char* a3 = a2 + kstep; const char* b3 = b2 + kstep;
            if (last && has_next) S.a_ready(nxt);
            if constexpr (SP2) {
            PG8_LDB(B0, 0, 0); PG8_LDB(B1, 0, 1); PG8_SCHED; PG8_LDA(At, 0, 0); PG8_STAGE(PG8_SA(1, 1), a1 + hstep, voffA);
            PG8_WAIT_V(8); PG8_WAIT_L(0); PG8_BAR; PG8_MMA(0, 0, At, B0); PG8_MMA(0, 1, At, B1); PG8_BAR; PG8_SCHED;
            PG8_LDA(At, 0, 1); PG8_STAGE(PG8_SB(0, 0), b2, voffB); PG8_STAGE(PG8_SB(0, 1), b2 + hstep, voffB); PG8_STAGE(PG8_SA(0, 0), a2, voffA);
            PG8_WAIT_V(8); PG8_WAIT_L(0); PG8_BAR; PG8_MMA(1, 0, At, B0); PG8_MMA(1, 1, At, B1); PG8_BAR; PG8_SCHED;
            PG8_LDB(B0, 1, 0); PG8_LDB(B1, 1, 1); PG8_SCHED; PG8_LDA(At, 1, 0); PG8_STAGE(PG8_SA(0, 1), a2 + hstep, voffA);
            PG8_WAIT_V(8); PG8_WAIT_L(0); PG8_BAR; PG8_MMA(0, 0, At, B0); PG8_MMA(0, 1, At, B1); PG8_BAR; PG8_SCHED;
            PG8_LDA(At, 1, 1); PG8_STAGE(PG8_SB(1, 0), b3, voffB); PG8_STAGE(PG8_SB(1, 1), b3 + hstep, voffB); PG8_STAGE(PG8_SA(1, 0), a3, voffA);
            PG8_WAIT_V(8); PG8_WAIT_L(0); PG8_BAR; PG8_MMA(1, 0, At, B0); PG8_MMA(1, 1, At, B1); PG8_BAR; PG8_SCHED;
            } else {
            PG8_LDB(B0, 0, 0); PG8_SCHED; PG8_LDA(At, 0, 0); PG8_STAGE(PG8_SA(1, 1), a1 + hstep, voffA);
            PG8_WAIT_L(8); PG8_BAR; PG8_WAIT_L(0); PG8_MMA(0, 0, At, B0); PG8_BAR; PG8_SCHED;
            PG8_LDB(B1, 0, 1); PG8_STAGE(PG8_SB(0, 0), b2, voffB);
            PG8_BAR; PG8_WAIT_L(0); PG8_MMA(0, 1, At, B1); PG8_BAR;
            PG8_LDA(At, 0, 1); PG8_STAGE(PG8_SA(0, 0), a2, voffA);
            PG8_BAR; PG8_WAIT_L(0); PG8_MMA(1, 0, At, B0); PG8_BAR; PG8_SCHED;
            PG8_STAGE(PG8_SB(0, 1), b2 + hstep, voffB);
            PG8_WAIT_V(6); PG8_BAR; PG8_MMA(1, 1, At, B1); PG8_BAR;
            PG8_LDB(B0, 1, 0); PG8_SCHED; PG8_LDA(At, 1, 0); PG8_STAGE(PG8_SA(0, 1), a2 + hstep, voffA);
            PG8_WAIT_L(8); PG8_BAR; PG8_WAIT_L(0); PG8_MMA(0, 0, At, B0); PG8_BAR; PG8_SCHED;
            PG8_LDB(B1, 1, 1); PG8_STAGE(PG8_SB(1, 0), b3, voffB);
            PG8_BAR; PG8_WAIT_L(0); PG8_MMA(0, 1, At, B1); PG8_BAR;
            PG8_LDA(At, 1, 1); PG8_STAGE(PG8_SA(1, 0), a3, voffA);
            PG8_BAR; PG8_WAIT_L(0); PG8_MMA(1, 0, At, B0); PG8_BAR; PG8_SCHED;
            PG8_STAGE(PG8_SB(1, 1), b3 + hstep, voffB);
            PG8_WAIT_V(6); PG8_BAR; PG8_MMA(1, 1, At, B1); PG8_BAR;
            }
        }
        if constexpr (ALIGN_EPI) { if (wr == 0) PG8_BAR; }
        if constexpr (!Epi::AFTER_DRAIN) { E(acc, cur, wr, wc, fr, fq); S.done(cur); }
        if (!has_next) break;
#pragma unroll
        for (int a = 0; a < 2; ++a)
#pragma unroll
            for (int b = 0; b < 2; ++b)
#pragma unroll
                for (int m = 0; m < 4; ++m)
#pragma unroll
                    for (int n = 0; n < 2; ++n) acc[a][b][m][n] = (f32x4){0.f, 0.f, 0.f, 0.f};
        cur = nxt; cA = nA; cB = nB; ++ui;
        if constexpr (ALIGN_EPI) { if (wr == 1) PG8_BAR; }
    }
    PG8_WAIT_V(0);
    if constexpr (!ALIGN_EPI) { if (wr == 0) PG8_BAR; }
    PG8_BAR;
    if constexpr (Epi::AFTER_DRAIN) { E.fused(acc, cur, wr, wc, fr, fq, lds, wid, lane); S.done(cur); }
#undef PG8_SA
#undef PG8_SB
#undef PG8_STAGE
#undef PG8_LDA
#undef PG8_LDB
#undef PG8_MMA
#undef PG8_WAIT_V
#undef PG8_WAIT_L
#undef PG8_BAR
#undef PG8_SCHED
}
}
#define LAS __attribute__((address_space(3)))
typedef float f32x4 __attribute__((ext_vector_type(4)));
constexpr int XSPLIT_TILE_ROWS = pg8::XSPLIT_TILE * 256;
#define XB_TMO      128
#define XB_XCNT(j)  (256  + 64 * (j))
#define XB_XSUB(j)  (1280 + 64 * (j))
#define XB_XGEN(j)  (2304 + 64 * (j))
#define XB_TOP      3328
#define XB_TOPGEN   3392
#define XCD_BAR_WORDS 3456
#define XB_SPIN_CAP (1u << 18)

__device__ __forceinline__ unsigned xb_ld(unsigned* p)              { return __hip_atomic_load(p, __ATOMIC_RELAXED, __HIP_MEMORY_SCOPE_AGENT); }
__device__ __forceinline__ unsigned xb_add(unsigned* p, unsigned v) { return __hip_atomic_fetch_add(p, v, __ATOMIC_RELAXED, __HIP_MEMORY_SCOPE_AGENT); }
__device__ __forceinline__ unsigned xb_xcc_id() { return (unsigned)__builtin_amdgcn_s_getreg((3 << 11) | 20) & 0xFu; }
#define XB_SPIN(cond, bar) do { unsigned _sp = 0; while (cond) { __builtin_amdgcn_s_sleep(1); \
    if ((++_sp & 255u) == 0u) { if (xb_ld(&(bar)[XB_TMO])) break; if (_sp > XB_SPIN_CAP) { atomicAdd(&(bar)[XB_TMO], 1u); break; } } } } while (0)

struct XcdBarrier {
    unsigned* bar; unsigned x;
    volatile LAS unsigned* st;
};

__device__ __forceinline__ XcdBarrier xcd_barrier_post(unsigned* bar, volatile LAS unsigned* st) {
    XcdBarrier b; b.bar = bar; b.x = xb_xcc_id(); b.st = st;
    if (threadIdx.x == 0) (void)xb_add(&bar[XB_XCNT(b.x)], 1u);
    return b;
}
__device__ __forceinline__ void xcd_barrier_complete(unsigned* bar, unsigned x, unsigned& nloc, unsigned& nx) {
    const unsigned G = gridDim.x * gridDim.y * gridDim.z;
    unsigned sum, cnt, mine, sp = 0u;
    for (;;) {
        sum = 0u; cnt = 0u; mine = 0u;
#pragma unroll
        for (unsigned j = 0; j < 16; ++j) { const unsigned c = xb_ld(&bar[XB_XCNT(j)]); sum += c; cnt += (c > 0u) ? 1u : 0u; mine = (j == x) ? c : mine; }
        if (sum == G) break;
        __builtin_amdgcn_s_sleep(1);
        if ((++sp & 255u) == 0u) { if (xb_ld(&bar[XB_TMO])) break; if (sp > XB_SPIN_CAP) { atomicAdd(&bar[XB_TMO], 1u); break; } }
    }
    nloc = mine > 0u ? mine : 1u; nx = cnt > 0u ? cnt : 1u;
}

__device__ __forceinline__ void xcd_barrier(const XcdBarrier& b) {
    asm volatile("s_waitcnt vmcnt(0)" ::: "memory");
    __syncthreads();
    if (threadIdx.x == 0) {
        unsigned* bar = b.bar;
        __builtin_amdgcn_s_waitcnt(0);
        unsigned nloc = b.st[0], nx = b.st[1];
        if (nloc == 0u) { xcd_barrier_complete(bar, b.x, nloc, nx); b.st[0] = nloc; b.st[1] = nx; }
        const unsigned old = xb_add(&bar[XB_XSUB(b.x)], 1u);
        const unsigned gen = old / nloc;
        if (old + 1u == (gen + 1u) * nloc) {
            __builtin_amdgcn_fence(__ATOMIC_RELEASE, "agent");
            asm volatile("s_waitcnt vmcnt(0)" ::: "memory");
            const unsigned og = xb_add(&bar[XB_TOP], 1u);
            const unsigned tg = og / nx;
            if (og + 1u == (tg + 1u) * nx) xb_add(&bar[XB_TOPGEN], 1u);
            else XB_SPIN(xb_ld(&bar[XB_TOPGEN]) == tg, bar);
            __builtin_amdgcn_fence(__ATOMIC_ACQUIRE, "agent");
            xb_add(&bar[XB_XGEN(b.x)], 1u);
            asm volatile("s_waitcnt vmcnt(0)" ::: "memory");
        } else {
            XB_SPIN(xb_ld(&bar[XB_XGEN(b.x)]) == gen, bar);
            __builtin_amdgcn_fence(__ATOMIC_ACQUIRE, "agent");
            asm volatile("s_waitcnt vmcnt(0)" ::: "memory");
        }
    }
    __syncthreads();
}

constexpr int NWAVES = 8, NTHREADS = 512;
#ifndef MK_ONE_LAUNCH
#define MK_ONE_LAUNCH 1
#endif
constexpr int D = 1024, DFF = 2816, NBATCH = 8, SEQ = 2048, DEC_B = 128, DEC_T = 4, NMETA = 16, NH = 4, DH = 128, DLRU = 512;
constexpr int R_SAMPLE = 16384, R_META = 16896, N_REAL = 16912, MP = 17152;
constexpr int NZ = 3072, NWIN = 3328, NUP = 5632;
constexpr float EPS = 1e-6f;
constexpr size_t O_YP = 0, O_YS = 16777216, O_PC = O_YS + 524288, O_PN = O_PC + 1048576, O_PM = O_PN + 8192, O_PH = O_PM + 64, O_PCONV = O_PH + 8192,
                 O_SC = O_PCONV + 24576, O_SN = O_SC + 16777216, O_SM = O_SN + 131072, O_SH = O_SM + 1024, O_SCONV = O_SH + 131072, O_END = O_SCONV + 393216;
constexpr size_t MiB = 1u << 20;
constexpr size_t WS_CTL = 0, CTL_ZERO_BYTES = 1 * MiB, WS_XTAIL = 1 * MiB, WS_G = 2 * MiB, WS_WGF = 2 * MiB + 768 * 1024  , WS_WB = 3 * MiB;
constexpr size_t LW_U1 = 0, LW_D1 = 11534336, LW_IN = 17301504, LW_O = 24117248, LW_U2 = 26214400, LW_D2 = 37748736, LW_SIZE = 43515904;
constexpr size_t WS_XN = 87 * MiB, WS_MIX = 121 * MiB, WS_HZ = 155 * MiB, WS_END = 256 * MiB;
static_assert(WS_WB + 2 * LW_SIZE <= WS_XN && WS_XN + (size_t)MP * D * 2 <= WS_MIX && WS_MIX + (size_t)MP * D * 2 <= WS_HZ && WS_HZ + (size_t)MP * NZ * 2 <= WS_END && (size_t)MP * DFF * 2 <= (size_t)MP * NZ * 2, "d_ws map");
constexpr int CW_BAR = 4096;
constexpr int RING_BYTES = 131072, LDSCTL_OFF = 143360, MISC_OFF = LDSCTL_OFF + 320, LDS_BYTES = 147456;

typedef unsigned short bf16;
typedef unsigned v4u __attribute__((ext_vector_type(4)));
typedef unsigned v2u __attribute__((ext_vector_type(2)));
#define LDS_WAIT() asm volatile("s_waitcnt lgkmcnt(0)" ::: "memory")
__device__ __forceinline__ unsigned f2bf(float f) { unsigned u = __builtin_bit_cast(unsigned, f); return (u + 0x7fffu + ((u >> 16) & 1u)) >> 16; }
__device__ __forceinline__ unsigned pk2(float lo, float hi) { return f2bf(lo) | (f2bf(hi) << 16); }
__device__ __forceinline__ float bf2f(bf16 v) { return __builtin_bit_cast(float, (unsigned)v << 16); }
__device__ __forceinline__ float wave_sum(float v) {
#pragma unroll
    for (int o = 1; o < 64; o <<= 1) v += __shfl_xor(v, o);
    return v;
}
__device__ __forceinline__ float sigmoid_f(float x) { return 1.0f / (1.0f + expf(-x)); }
__device__ __forceinline__ float fexp(float x) { return __builtin_amdgcn_exp2f(x * 1.4426950408889634f); }
__device__ __forceinline__ float frcp(float x) { return __builtin_amdgcn_rcpf(x); }
__device__ __forceinline__ float frsq(float x) { return __builtin_amdgcn_rsqf(x); }
__device__ __forceinline__ float fsigmoid(float x) { return frcp(1.0f + fexp(-x)); }
__device__ __forceinline__ float fgelu_tanh(float x) { const float u = 1.5957691216057308f * (x + 0.044715f * x * x * x); return x * frcp(1.0f + fexp(-u)); }
__device__ __forceinline__ float softplus_f(float x) { return fmaxf(x, 0.f) + log1pf(expf(-fabsf(x))); }
__device__ __forceinline__ float gelu_tanh_f(float x) { const float u = 0.7978845608028654f * (x + 0.044715f * x * x * x); return 0.5f * x * (1.0f + tanhf(u)); }

struct Args { const float* in[30]; float* out; unsigned char* ws; int ph_lo, ph_hi, li, pad; };
struct Ctx { volatile LAS unsigned* tab; float* out; unsigned char* ws; };
__device__ __forceinline__ const float* inp(const Ctx& a, int i) { const unsigned lo = __builtin_amdgcn_readfirstlane(a.tab[2 * i]), hi = __builtin_amdgcn_readfirstlane(a.tab[2 * i + 1]); return (const float*)(((unsigned long long)hi << 32) | lo); }
enum { I_XP = 0, I_XS, I_SC, I_SN, I_SM, I_SH, I_SCONV, I_META, I_GFF1, I_W1G, I_W1U, I_W1D, I_GMIX, I_WIN, I_BG, I_CW, I_CB, I_WRA, I_BRA, I_WRX, I_BRX, I_LAM, I_GMO, I_GLO, I_WOUT, I_GFF2, I_W2G, I_W2U, I_W2D, I_GFIN };

__device__ __forceinline__ float* xrow_ptr(const Ctx& a, int r) { return r < XSPLIT_TILE_ROWS ? a.out + (size_t)r * D : (float*)(a.ws + WS_XTAIL) + (size_t)(r - XSPLIT_TILE_ROWS) * D; }

__device__ __forceinline__ void conv_item(const float* W, int K, int Nsrc, int sc0, int nvalid, const float* gamma, float rs, bf16* WT, int n0, int k0, LAS float* scr, int lane) {
#pragma unroll 8
    for (int i = 0; i < 32; ++i) { const int kk = 2 * i + (lane >> 5), j = lane & 31; float v = 0.f;
        if (j < nvalid) { v = W[(size_t)(k0 + kk) * Nsrc + sc0 + j] * rs; if (gamma) v *= gamma[k0 + kk]; }
        scr[kk * 33 + j] = v; }
    LDS_WAIT(); asm volatile("" ::: "memory");
    const int c = lane & 7;
#pragma unroll
    for (int j = 0; j < 4; ++j) { const int n = (lane >> 3) + 8 * j; const LAS float* s = scr + (8 * c) * 33 + n;
        v4u o; o.x = pk2(s[0 * 33], s[1 * 33]); o.y = pk2(s[2 * 33], s[3 * 33]); o.z = pk2(s[4 * 33], s[5 * 33]); o.w = pk2(s[6 * 33], s[7 * 33]);
        *(v4u*)(WT + (size_t)(n0 + n) * K + k0 + 8 * c) = o; }
    LDS_WAIT(); asm volatile("" ::: "memory");
}
constexpr int IT_U = 16 * 176, IT_D = 44 * 32, IT_IN = 16 * 104, IT_O = 16 * 32, IT_LAYER = 2 * IT_U + 2 * IT_D + IT_IN + IT_O;
__device__ __forceinline__ void conv_dispatch(const Ctx& a, int it, LAS float* scr, int lane) {
    const int l = it / IT_LAYER; int r = it % IT_LAYER;
    unsigned char* wb = a.ws + WS_WB + (size_t)l * LW_SIZE;
    if (r < 2 * IT_U) {
        const int second = r >= IT_U; if (second) r -= IT_U;
        const int nb = r % 176, kb = r / 176, n0 = nb * 32, grp = n0 >> 8, w = n0 & 255;
        const float* src = inp(a, second ? (w < 128 ? I_W2G : I_W2U) : (w < 128 ? I_W1G : I_W1U)) + (size_t)l * D * DFF;
        conv_item(src, D, DFF, grp * 128 + (w & 127), 32, inp(a, second ? I_GFF2 : I_GFF1) + l * D, 1.f, (bf16*)(wb + (second ? LW_U2 : LW_U1)), n0, kb * 64, scr, lane);
        return; }
    r -= 2 * IT_U;
    if (r < 2 * IT_D) {
        const int second = r >= IT_D; if (second) r -= IT_D;
        const int nb = r % 32, kb = r / 32;
        conv_item(inp(a, second ? I_W2D : I_W1D) + (size_t)l * DFF * D, DFF, D, nb * 32, 32, nullptr, 1.f, (bf16*)(wb + (second ? LW_D2 : LW_D1)), nb * 32, kb * 64, scr, lane);
        return; }
    r -= 2 * IT_D;
    if (r < IT_IN) {
        const int nb = r % 104, kb = r / 104, n0 = nb * 32; int sc0, nvalid = 32; float rs = 1.f;
        if (n0 < 2048) { sc0 = n0; if (n0 >= 512 && n0 < 1024) rs = 0.08838834764831845f; }
        else if (n0 < 3072) sc0 = n0 + 8;
        else if (n0 == 3072) { sc0 = 2048; nvalid = 8; }
        else { sc0 = 0; nvalid = 0; }
        conv_item(inp(a, I_WIN) + (size_t)l * D * 3080, D, 3080, sc0, nvalid, inp(a, I_GMIX) + l * D, rs, (bf16*)(wb + LW_IN), n0, kb * 64, scr, lane);
        return; }
    r -= IT_IN;
    { const int nb = r % 32, kb = r / 32;
      conv_item(inp(a, I_WOUT) + (size_t)l * D * D, D, D, nb * 32, 32, nullptr, 1.f, (bf16*)(wb + LW_O), nb * 32, kb * 64, scr, lane); }
}
__device__ __forceinline__ void norm_row_to_bf16(const float* xrow, bf16* orow, int lane) {
    const f32x4* xr = (const f32x4*)xrow + lane; f32x4 v[4]; float s = 0.f;
#pragma unroll
    for (int j = 0; j < 4; ++j) { v[j] = xr[64 * j]; s += (v[j].x * v[j].x + v[j].y * v[j].y) + (v[j].z * v[j].z + v[j].w * v[j].w); }
    const float rstd = 1.f / sqrtf(wave_sum(s) * (1.f / D) + EPS);
    unsigned long long* o8 = (unsigned long long*)orow + lane;
#pragma unroll
    for (int j = 0; j < 4; ++j) o8[64 * j] = (unsigned long long)pk2(v[j].x * rstd, v[j].y * rstd) | ((unsigned long long)pk2(v[j].z * rstd, v[j].w * rstd) << 32);
}

__device__ __forceinline__ void mlstm_naive_item(const Ctx& a, int l, int item, LAS float* sm, int tid) {
    const int lane = tid & 63, wave = tid >> 6, e = tid >> 2, qd = tid & 3, d0 = 32 * qd;
    const bool prompt = item < 32; const int b = prompt ? item >> 2 : (item - 32) >> 2, h = prompt ? item & 3 : (item - 32) & 3;
    const bf16* Z = (const bf16*)(a.ws + WS_HZ); const float* G = (const float*)(a.ws + WS_G); bf16* MIX = (bf16*)(a.ws + WS_MIX);
    LAS float* qs = sm; LAS float* ks = sm + 128; LAS float* red = sm + 256; LAS float* red2 = sm + 264;
    float C[32]; float nreg = 0.f, m = 0.f;
#pragma unroll
    for (int j = 0; j < 32; ++j) C[j] = 0.f;
    if (!prompt) {
        const float* C0 = inp(a, I_SC) + ((size_t)(l * DEC_B + b) * NH + h) * DH * DH + (size_t)e * DH + d0;
#pragma unroll
        for (int j = 0; j < 32; ++j) C[j] = C0[j];
        if (tid < 128) nreg = inp(a, I_SN)[((size_t)(l * DEC_B + b) * NH + h) * DH + tid];
        m = inp(a, I_SM)[(l * DEC_B + b) * NH + h];
    }
    const float big = inp(a, I_BG)[l * 8 + h], bfg = inp(a, I_BG)[l * 8 + 4 + h];
    const float gm = inp(a, I_GMO)[l * 512 + h * DH + e];
    const int nsteps = prompt ? NMETA + SEQ : DEC_T;
    for (int t = 0; t < nsteps; ++t) {
        const int row = prompt ? (t < NMETA ? R_META + t : b * SEQ + (t - NMETA)) : R_SAMPLE + b * DEC_T + t;
        const bf16* zr = Z + (size_t)row * NZ;
        if (tid < 128) { qs[tid] = bf2f(zr[h * DH + tid]); ks[tid] = bf2f(zr[512 + h * DH + tid]); }
        const float ve = bf2f(zr[1024 + h * DH + e]), oe = bf2f(zr[1536 + h * DH + e]);
        const float ig = G[(size_t)row * 8 + h] + big, fg = G[(size_t)row * 8 + 4 + h] + bfg;
        const float logf = -softplus_f(-fg);
        const float mn = fmaxf(logf + m, ig), decay = expf(logf + m - mn), igw = expf(ig - mn);
        m = mn;
        __syncthreads();
        float num = 0.f; const float iv = igw * ve;
#pragma unroll
        for (int j = 0; j < 32; ++j) { C[j] = decay * C[j] + iv * ks[d0 + j]; num += C[j] * qs[d0 + j]; }
        num += __shfl_xor(num, 1); num += __shfl_xor(num, 2);
        float pd = 0.f;
        if (tid < 128) { nreg = decay * nreg + igw * ks[tid]; pd = nreg * qs[tid]; }
        if (wave < 2) { pd = wave_sum(pd); if (lane == 0) red[wave] = pd; }
        __syncthreads();
        const float den = red[0] + red[1];
        const float hv = num / fmaxf(fabsf(den), expf(-mn));
        float sq = (qd == 0) ? hv * hv : 0.f; sq = wave_sum(sq); if (lane == 0) red2[wave] = sq;
        __syncthreads();
        float ss = 0.f;
#pragma unroll
        for (int w = 0; w < 8; ++w) ss += red2[w];
        if (qd == 0 && (!prompt || t >= NMETA || b == 0)) {
            const float y = hv * (1.0f / sqrtf(ss * (1.f / DH) + EPS)) * gm * sigmoid_f(oe);
            MIX[(size_t)row * D + h * DH + e] = (bf16)f2bf(y);
        }
    }
    float* oC = a.out + (prompt ? O_PC + ((size_t)(l * NBATCH + b) * NH + h) * DH * DH : O_SC + ((size_t)(l * DEC_B + b) * NH + h) * DH * DH) + (size_t)e * DH + d0;
#pragma unroll
    for (int j = 0; j < 32; ++j) oC[j] = C[j];
    if (tid < 128) a.out[(prompt ? O_PN + ((size_t)(l * NBATCH + b) * NH + h) * DH : O_SN + ((size_t)(l * DEC_B + b) * NH + h) * DH) + tid] = nreg;
    if (tid == 0) a.out[prompt ? O_PM + (l * NBATCH + b) * NH + h : O_SM + (l * DEC_B + b) * NH + h] = m;
    __syncthreads();
}
__device__ __forceinline__ void lru_naive_item(const Ctx& a, int l, int item, LAS float* sm, int tid) {
    const int lane = tid & 63, wave = tid >> 6, c = tid;
    const bool prompt = item < 8; const int b = prompt ? item : item - 8;
    const bf16* Z = (const bf16*)(a.ws + WS_HZ); bf16* MIX = (bf16*)(a.ws + WS_MIX);
    LAS float* red = sm + 33024;
    LAS float* wxs = sm + wave * 4096 + lane;
    float wa[64];
    { const float* pa = inp(a, I_WRA) + (size_t)(l * 8 + wave) * 4096 + lane; const float* px = inp(a, I_WRX) + (size_t)(l * 8 + wave) * 4096 + lane;
#pragma unroll
      for (int d = 0; d < 64; ++d) { wa[d] = pa[d * 64]; wxs[d * 64] = px[d * 64]; } }
    const float cw0 = inp(a, I_CW)[(l * 4 + 0) * 512 + c], cw1 = inp(a, I_CW)[(l * 4 + 1) * 512 + c], cw2 = inp(a, I_CW)[(l * 4 + 2) * 512 + c], cw3 = inp(a, I_CW)[(l * 4 + 3) * 512 + c];
    const float cb = inp(a, I_CB)[l * 512 + c], ba = inp(a, I_BRA)[l * 512 + c], bx = inp(a, I_BRX)[l * 512 + c];
    const float sp = 8.0f * softplus_f(-inp(a, I_LAM)[l * 512 + c]), gl = inp(a, I_GLO)[l * 512 + c];
    float x3 = 0.f, x2 = 0.f, x1 = 0.f, hst = 0.f;
    if (!prompt) { const float* cs = inp(a, I_SCONV) + (size_t)(l * DEC_B + b) * 3 * 512; x3 = cs[c]; x2 = cs[512 + c]; x1 = cs[1024 + c]; hst = inp(a, I_SH)[(size_t)(l * DEC_B + b) * 512 + c]; }
    const int nsteps = prompt ? NMETA + SEQ : DEC_T;
    for (int t = 0; t < nsteps; ++t) {
        const int row = prompt ? (t < NMETA ? R_META + t : b * SEQ + (t - NMETA)) : R_SAMPLE + b * DEC_T + t;
        const bf16* zr = Z + (size_t)row * NZ;
        const float x0 = bf2f(zr[2048 + c]), yg = bf2f(zr[2560 + c]);
        const float xc = cb + x3 * cw0 + x2 * cw1 + x1 * cw2 + x0 * cw3;
        float ra = ba, ri = bx;
#pragma unroll
        for (int d = 0; d < 64; ++d) { const float xd = __builtin_bit_cast(float, __builtin_amdgcn_readlane(__builtin_bit_cast(int, xc), d)); ra += xd * wa[d]; ri += xd * wxs[d * 64]; }
        const float r = sigmoid_f(ra), ig = sigmoid_f(ri);
        const float log_a = -sp * r, av = expf(log_a), bin = sqrtf(-expm1f(2.0f * log_a)) * (ig * xc);
        hst = av * hst + bin;
        float sq = wave_sum(hst * hst); LAS float* rp = red + (t & 1) * 8; if (lane == 0) rp[wave] = sq;
        __syncthreads();
        float ss = 0.f;
#pragma unroll
        for (int w = 0; w < 8; ++w) ss += rp[w];
        if (!prompt || t >= NMETA || b == 0) {
            const float y = hst * (1.0f / sqrtf(ss * (1.f / 512.f) + EPS)) * gl * gelu_tanh_f(yg);
            MIX[(size_t)row * D + 512 + c] = (bf16)f2bf(y);
        }
        x3 = x2; x2 = x1; x1 = x0;
    }
    if (prompt) { a.out[O_PH + (size_t)(l * NBATCH + b) * 512 + c] = hst; float* pc = a.out + O_PCONV + (size_t)(l * NBATCH + b) * 3 * 512; pc[c] = x3; pc[512 + c] = x2; pc[1024 + c] = x1; }
    else { a.out[O_SH + (size_t)(l * DEC_B + b) * 512 + c] = hst; float* pc = a.out + O_SCONV + (size_t)(l * DEC_B + b) * 3 * 512; pc[c] = x3; pc[512 + c] = x2; pc[1024 + c] = x1; }
    __syncthreads();
}


constexpr size_t AG_LA = 0, AG_LH = 1 * MiB, AG_DC = 2 * MiB, AG_DN = AG_DC + (size_t)260 * 65536, AG_SC = AG_DN + (size_t)260 * 512, AG_END = AG_SC + 260 * 8;
static_assert(AG_END <= (size_t)MP * D * 2 && (size_t)257 * 512 * 4 <= MiB, "aggregate scratch fits the XN region");
typedef short bf16x8_t __attribute__((ext_vector_type(8)));
typedef short bf16x4_t __attribute__((ext_vector_type(4)));
constexpr int LRU_UNITS = 257;

template <int MODE, bool SAMPLE = false>
__device__ __forceinline__ void lru_unit(const Ctx& a, int l, int unit, LAS unsigned char* lds, int tid) {
    const int lane = tid & 63, w = __builtin_amdgcn_readfirstlane(tid >> 6), fr = lane & 15, g = lane >> 4;
    const bool meta = !SAMPLE && unit == 0; const int b = (SAMPLE || meta) ? 0 : (unit - 1) >> 5, c = (SAMPLE || meta) ? 0 : (unit - 1) & 31;
    const int row0 = SAMPLE ? R_SAMPLE + 64 * unit : (meta ? R_META : b * SEQ + c * 64), nvalid = meta ? NMETA : 64;
    const bf16* Z = (const bf16*)(a.ws + WS_HZ); bf16* MIX = (bf16*)(a.ws + WS_MIX);
    float* LA = (float*)(a.ws + WS_XN + AG_LA); float* LH = (float*)(a.ws + WS_XN + AG_LH);
    LAS bf16* xcS = (LAS bf16*)(lds + w * 4608);
    LAS float* ssS = (LAS float*)(lds + 36864);
    const int chg = 64 * w + lane;
    const float cw0 = inp(a, I_CW)[(l * 4 + 0) * 512 + chg], cw1 = inp(a, I_CW)[(l * 4 + 1) * 512 + chg], cw2 = inp(a, I_CW)[(l * 4 + 2) * 512 + chg], cw3 = inp(a, I_CW)[(l * 4 + 3) * 512 + chg];
    const float cb = inp(a, I_CB)[l * 512 + chg];
    float ba[4], bx[4], sp[4], gl[4];
#pragma unroll
    for (int n = 0; n < 4; ++n) { const int cd = 64 * w + 16 * n + fr; ba[n] = inp(a, I_BRA)[l * 512 + cd]; bx[n] = inp(a, I_BRX)[l * 512 + cd];
        sp[n] = 8.0f * softplus_f(-inp(a, I_LAM)[l * 512 + cd]); gl[n] = inp(a, I_GLO)[l * 512 + cd]; }
    bf16x8_t wfA[4][2], wfX[4][2];
    { const bf16x8_t* wg = (const bf16x8_t*)(a.ws + WS_WGF) + (size_t)(l * 8 + w) * 2 * 8 * 64 + lane;
#pragma unroll
      for (int n = 0; n < 4; ++n)
#pragma unroll
        for (int kk = 0; kk < 2; ++kk) { wfA[n][kk] = wg[(n * 2 + kk) * 64]; wfX[n][kk] = wg[(8 + n * 2 + kk) * 64]; } }
    float x3 = 0.f, x2 = 0.f, x1 = 0.f;
    if (!meta && !SAMPLE) { const int p3 = c == 0 ? R_META + 13 : row0 - 3;
        x3 = bf2f(Z[(size_t)p3 * NZ + 2048 + chg]); x2 = bf2f(Z[(size_t)(p3 + 1) * NZ + 2048 + chg]); x1 = bf2f(Z[(size_t)(p3 + 2) * NZ + 2048 + chg]); }
    float hin[4] = {0.f, 0.f, 0.f, 0.f}, Atot[4] = {1.f, 1.f, 1.f, 1.f};
    if (MODE == 1 && !meta && !SAMPLE) {
#pragma unroll
        for (int n = 0; n < 4; ++n) hin[n] = LH[64 * w + 16 * n + fr];
        for (int c0 = 0; c0 < c; c0 += 4) {
            float la[4][4], lh[4][4];
#pragma unroll
            for (int q = 0; q < 4; ++q) { const int cc = (c0 + q < c) ? c0 + q : c - 1; const size_t u = (size_t)(1 + b * 32 + cc) * 512 + 64 * w + fr;
#pragma unroll
                for (int n = 0; n < 4; ++n) { la[q][n] = LA[u + 16 * n]; lh[q][n] = LH[u + 16 * n]; } }
#pragma unroll
            for (int q = 0; q < 4; ++q) if (c0 + q < c) {
#pragma unroll
                for (int n = 0; n < 4; ++n) hin[n] = la[q][n] * hin[n] + lh[q][n]; }
        }
    }
    const int nhalf = meta ? 1 : 2;
    for (int hh = 0; hh < nhalf; ++hh) {
        bf16 xraw[32];
        { const bf16* zp = Z + (size_t)(row0 + 32 * hh) * NZ + 2048 + chg;
#pragma unroll
          for (int tt = 0; tt < 32; ++tt) xraw[tt] = zp[(size_t)tt * NZ]; }
#pragma unroll
        for (int tt = 0; tt < 32; ++tt) { const int tok = 32 * hh + tt; float x0 = 0.f;
            if (SAMPLE && (tt & 3) == 0) { const float* cs = inp(a, I_SCONV) + (size_t)(l * DEC_B + 16 * unit + (tok >> 2)) * 3 * 512; x3 = cs[chg]; x2 = cs[512 + chg]; x1 = cs[1024 + chg]; }
            if (tok < nvalid) x0 = bf2f(xraw[tt]);
            const float xc = cb + x3 * cw0 + x2 * cw1 + x1 * cw2 + x0 * cw3;
            xcS[tt * 72 + lane] = (bf16)f2bf(xc);
            if (tok < nvalid) { x3 = x2; x2 = x1; x1 = x0; }
            if (SAMPLE && (tt & 3) == 3) { float* pc = a.out + O_SCONV + (size_t)(l * DEC_B + 16 * unit + (tok >> 2)) * 3 * 512; pc[chg] = x3; pc[512 + chg] = x2; pc[1024 + chg] = x1; } }
        LDS_WAIT(); asm volatile("" ::: "memory");
#pragma unroll 1
        for (int m = 0; m < 2; ++m) {
            float hval[4][4];
            f32x4 accR[4], accI[4];
#pragma unroll
            for (int n = 0; n < 4; ++n) { accR[n] = (f32x4){0.f, 0.f, 0.f, 0.f}; accI[n] = (f32x4){0.f, 0.f, 0.f, 0.f}; }
#pragma unroll
            for (int kk = 0; kk < 2; ++kk) { const bf16x8_t af = *(const LAS bf16x8_t*)(xcS + (16 * m + fr) * 72 + 32 * kk + 8 * g);
#pragma unroll
                for (int n = 0; n < 4; ++n) { accR[n] = __builtin_amdgcn_mfma_f32_16x16x32_bf16(af, wfA[n][kk], accR[n], 0, 0, 0); accI[n] = __builtin_amdgcn_mfma_f32_16x16x32_bf16(af, wfX[n][kk], accI[n], 0, 0, 0); } }
#pragma unroll
            for (int n = 0; n < 4; ++n) {
                float av[4], bv[4];
#pragma unroll
                for (int i = 0; i < 4; ++i) { const int tt = 16 * m + 4 * g + i, tok = 32 * hh + tt;
                    const float r = fsigmoid(accR[n][i] + ba[n]), ig = fsigmoid(accI[n][i] + bx[n]);
                    const float log_a = -sp[n] * r, xcv = bf2f(xcS[tt * 72 + 16 * n + fr]);
                    const bool valid = tok < nvalid; const float ae = fexp(log_a);
                    av[i] = valid ? ae : 1.f; bv[i] = valid ? __builtin_amdgcn_sqrtf(fmaxf(1.0f - ae * ae, 0.f)) * (ig * xcv) : 0.f; }
                float Al = av[0], Hl = bv[0];
#pragma unroll
                for (int i = 1; i < 4; ++i) { Hl = av[i] * Hl + bv[i]; Al *= av[i]; }
                const float A1 = __shfl_xor(Al, 16), H1 = __shfl_xor(Hl, 16);
                const bool odd = g & 1;
                const float Apair = Al * A1, Hpair = odd ? (Al * H1 + Hl) : (A1 * Hl + H1);
                const float Awin = odd ? A1 : 1.f, Hwin = odd ? H1 : 0.f;
                const float A2 = __shfl_xor(Apair, 32), H2 = __shfl_xor(Hpair, 32);
                const bool hi = g & 2;
                const float Apre = hi ? A2 * Awin : Awin, Hpre = hi ? (Awin * H2 + Hwin) : Hwin;
                const float At = Apair * A2, Ht = hi ? (Apair * H2 + Hpair) : (A2 * Hpair + H2);
                if (SAMPLE) { const int sb = 16 * unit + 8 * hh + 4 * m + g; const int cd = 64 * w + 16 * n + fr;
                    float hs = inp(a, I_SH)[(size_t)(l * DEC_B + sb) * 512 + cd];
#pragma unroll
                    for (int i = 0; i < 4; ++i) { hs = av[i] * hs + bv[i]; hval[n][i] = hs; }
                    a.out[O_SH + (size_t)(l * DEC_B + sb) * 512 + cd] = hs;
                } else {
                if (MODE == 1) { float hs = Apre * hin[n] + Hpre;
#pragma unroll
                    for (int i = 0; i < 4; ++i) { hs = av[i] * hs + bv[i]; hval[n][i] = hs; } }
                hin[n] = At * hin[n] + Ht; Atot[n] *= At; }
            }
            if (MODE == 1) {
#pragma unroll
                for (int i = 0; i < 4; ++i) { float s = 0.f;
#pragma unroll
                    for (int n = 0; n < 4; ++n) s += hval[n][i] * hval[n][i];
                    s += __shfl_xor(s, 1); s += __shfl_xor(s, 2); s += __shfl_xor(s, 4); s += __shfl_xor(s, 8);
                    if (fr == 0) ssS[(m * 8 + w) * 32 + 4 * g + i] = s; }
                __syncthreads();
#pragma unroll
                for (int i = 0; i < 4; ++i) { const int tt = 16 * m + 4 * g + i, tok = 32 * hh + tt; float ss = 0.f;
#pragma unroll
                    for (int ww = 0; ww < 8; ++ww) ss += ssS[(m * 8 + ww) * 32 + 4 * g + i];
                    const float inv = frsq(ss * (1.f / 512.f) + EPS);
                    if (tok < nvalid) { const unsigned row = (unsigned)(row0 + tok);
#pragma unroll
                        for (int n = 0; n < 4; ++n) { const unsigned cd = 64 * w + 16 * n + fr; const float yg = bf2f(Z[row * NZ + 2560 + cd]);
                            MIX[row * D + 512 + cd] = (bf16)f2bf(hval[n][i] * inv * gl[n] * fgelu_tanh(yg)); } } }
            }
        }
        asm volatile("" ::: "memory");
    }
    if (MODE == 0) { if (g == 0) {
#pragma unroll
        for (int n = 0; n < 4; ++n) { const int cd = 64 * w + 16 * n + fr; LA[(size_t)unit * 512 + cd] = Atot[n]; LH[(size_t)unit * 512 + cd] = hin[n]; } } }
    else if (!SAMPLE && !meta && c == 31) {
        if (g == 0) {
#pragma unroll
            for (int n = 0; n < 4; ++n) a.out[O_PH + (size_t)(l * NBATCH + b) * 512 + 64 * w + 16 * n + fr] = hin[n]; }
        float* pc = a.out + O_PCONV + (size_t)(l * NBATCH + b) * 3 * 512; pc[chg] = x3; pc[512 + chg] = x2; pc[1024 + chg] = x1;
    }
    __syncthreads();
}

constexpr int ML_UNITS = 260;
constexpr int TS = 264;
constexpr int CS = 136;
#define NEG_INF (-__builtin_inff())

__device__ __forceinline__ void gates_scan(const float* G, int row0, int nvalid, int h, float big, float bfg, LAS float* bS, LAS float* uS, LAS float* gS, int lane) {
    float cs[4], ig[4];
#pragma unroll
    for (int i = 0; i < 4; ++i) { const int tok = 4 * lane + i; const bool valid = tok < nvalid; const float* gr = G + (size_t)(row0 + tok) * 8;
        const float gi = gr[h] + big, gf = gr[4 + h] + bfg; ig[i] = valid ? gi : NEG_INF; cs[i] = valid ? -softplus_f(-gf) : 0.f; }
    cs[1] += cs[0]; cs[2] += cs[1]; cs[3] += cs[2];
    float incl = cs[3];
#pragma unroll
    for (int off = 1; off < 64; off <<= 1) { const float t = __shfl_up(incl, off); if (lane >= off) incl += t; }
    const float excl = incl - cs[3];
    float u[4], r[4];
#pragma unroll
    for (int i = 0; i < 4; ++i) { cs[i] += excl; u[i] = ig[i] - cs[i]; }
    r[0] = u[0]; r[1] = fmaxf(r[0], u[1]); r[2] = fmaxf(r[1], u[2]); r[3] = fmaxf(r[2], u[3]);
    float imax = r[3];
#pragma unroll
    for (int off = 1; off < 64; off <<= 1) { const float t = __shfl_up(imax, off); if (lane >= off) imax = fmaxf(imax, t); }
    float pre = __shfl_up(imax, 1); if (lane == 0) pre = NEG_INF;
#pragma unroll
    for (int i = 0; i < 4; ++i) { bS[4 * lane + i] = cs[i]; uS[4 * lane + i] = u[i]; gS[4 * lane + i] = fmaxf(pre, r[i]); }
}
__device__ __forceinline__ unsigned off_b(unsigned row, unsigned ch) { return 256u * row + 16u * (ch ^ (((row & 3) << 2) | ((row >> 2) & 3))); }
__device__ __forceinline__ bf16x8_t tr_frag(const LAS unsigned char* img, unsigned lane, unsigned c, unsigned ks) {
    const unsigned g = lane >> 4, q = (lane & 15) >> 2, p = lane & 3;
    const bf16x4_t lo = __builtin_amdgcn_ds_read_tr16_b64_v4i16((LAS bf16x4_t*)(img + off_b(32 * ks + 8 * g + q, 2 * c + (p >> 1)) + 8 * (p & 1)));
    const bf16x4_t hi = __builtin_amdgcn_ds_read_tr16_b64_v4i16((LAS bf16x4_t*)(img + off_b(32 * ks + 8 * g + 4 + q, 2 * c + (p >> 1)) + 8 * (p & 1)));
    return __builtin_shufflevector(lo, hi, 0, 1, 2, 3, 4, 5, 6, 7);
}
__device__ __forceinline__ void img_load(const bf16* Zc, int row0, v4u (&r)[8], int tid) {
#pragma unroll
    for (int i = 0; i < 8; ++i) { const int n = tid + 512 * i; r[i] = *(const v4u*)(Zc + (size_t)(row0 + (n >> 4)) * NZ + 8 * (n & 15)); }
}
template <bool SCALE>
__device__ __forceinline__ void img_store(LAS unsigned char* img, const v4u (&r)[8], const LAS float* wS, int tid) {
#pragma unroll
    for (int i = 0; i < 8; ++i) { const int n = tid + 512 * i, row = n >> 4; v4u v = r[i];
        if (SCALE) { const float ws = wS[row];
#pragma unroll
            for (int j = 0; j < 4; ++j) v[j] = pk2(__builtin_bit_cast(float, v[j] << 16) * ws, __builtin_bit_cast(float, v[j] & 0xffff0000u) * ws); }
        *(LAS v4u*)(img + off_b(row, n & 15)) = v; }
}

template <int MODE>
__device__ __forceinline__ void mlstm_unit(const Ctx& a, int l, int unit, LAS unsigned char* lds, int tid) {
    const int lane = tid & 63, w = __builtin_amdgcn_readfirstlane(tid >> 6), fr = lane & 15, g = lane >> 4;
    const bool meta = unit < 4; const int bh = meta ? 0 : (unit - 4) >> 3, c = meta ? 0 : (unit - 4) & 7, b = bh >> 2, h = meta ? unit : bh & 3;
    const int row0 = meta ? R_META : b * SEQ + c * 256, nvalid = meta ? NMETA : 256;
    const bf16* Z = (const bf16*)(a.ws + WS_HZ); const float* G = (const float*)(a.ws + WS_G); bf16* MIX = (bf16*)(a.ws + WS_MIX);
    float* DC = (float*)(a.ws + WS_XN + AG_DC); float* DN = (float*)(a.ws + WS_XN + AG_DN); float* SC = (float*)(a.ws + WS_XN + AG_SC);
    LAS unsigned char* VIMG = lds;
    LAS unsigned char* KIMG = lds + 65536;
    LAS bf16* C0 = (LAS bf16*)(lds + 65536);
    LAS float* bS = (LAS float*)(lds + 139264); LAS float* uS = bS + 256; LAS float* gS = bS + 512; LAS float* wS = bS + 768;
    const int hq = h * DH;
    if (w == 0) gates_scan(G, row0, nvalid, h, inp(a, I_BG)[l * 8 + h], inp(a, I_BG)[l * 8 + 4 + h], bS, uS, gS, lane);
    if (MODE == 0) {
        v4u vr[8], kr[8];
        img_load(Z + 1024 + hq, row0, vr, tid); img_load(Z + 512 + hq, row0, kr, tid);
        __syncthreads();
        const float umax = gS[255], Btot = bS[255];
        if (tid < 256) wS[tid] = expf(uS[tid] - umax);
        __syncthreads();
        img_store<true>(VIMG, vr, wS, tid); img_store<false>(KIMG, kr, wS, tid);
        __syncthreads();
        f32x4 acc[8];
#pragma unroll
        for (int n = 0; n < 8; ++n) acc[n] = (f32x4){0.f, 0.f, 0.f, 0.f};
#pragma unroll 2
        for (int ks = 0; ks < 8; ++ks) { const bf16x8_t af = tr_frag(VIMG, lane, w, ks);
#pragma unroll
            for (int n = 0; n < 8; ++n) { const bf16x8_t bf = tr_frag(KIMG, lane, n, ks); acc[n] = __builtin_amdgcn_mfma_f32_16x16x32_bf16(af, bf, acc[n], 0, 0, 0); } }
        float* dc = DC + (size_t)unit * 16384;
#pragma unroll
        for (int n = 0; n < 8; ++n)
#pragma unroll
            for (int i = 0; i < 4; ++i) dc[(16 * w + 4 * g + i) * 128 + 16 * n + fr] = acc[n][i];
        if (tid < 128) { float s = 0.f;
#pragma unroll 16
            for (int t = 0; t < 256; ++t) s += wS[t] * bf2f(*(const LAS bf16*)(KIMG + off_b(t, tid >> 3) + 2 * (tid & 7)));
            DN[(size_t)unit * 128 + tid] = s; }
        if (tid == 0) { SC[unit * 2] = Btot; SC[unit * 2 + 1] = Btot + umax; }
        __syncthreads();
        return;
    }
    const int np = meta ? 0 : 1 + c;
    f32x4 cr[8]; float nr = 0.f, m0 = 0.f;
#pragma unroll
    for (int j = 0; j < 8; ++j) cr[j] = (f32x4){0.f, 0.f, 0.f, 0.f};
    for (int p = 0; p < np; ++p) { const int ua = p == 0 ? h : 4 + bh * 8 + (p - 1);
        const float Bj = SC[ua * 2], mlj = SC[ua * 2 + 1], mn = fmaxf(mlj, Bj + m0), dec = expf(Bj + m0 - mn), inw = expf(mlj - mn); m0 = mn;
        const f32x4* src = (const f32x4*)(DC + (size_t)ua * 16384) + tid;
#pragma unroll
        for (int j = 0; j < 8; ++j) cr[j] = cr[j] * dec + src[512 * j] * inw;
        if (tid < 128) nr = nr * dec + DN[(size_t)ua * 128 + tid] * inw; }
    if (!meta && c == 7) {
        const float Bj = SC[unit * 2], mlj = SC[unit * 2 + 1], mn = fmaxf(mlj, Bj + m0), dec = expf(Bj + m0 - mn), inw = expf(mlj - mn);
        const f32x4* src = (const f32x4*)(DC + (size_t)unit * 16384) + tid; f32x4* dst = (f32x4*)(a.out + O_PC + ((size_t)(l * NBATCH + b) * NH + h) * DH * DH) + tid;
#pragma unroll
        for (int j = 0; j < 8; ++j) dst[512 * j] = cr[j] * dec + src[512 * j] * inw;
        if (tid < 128) a.out[O_PN + ((size_t)(l * NBATCH + b) * NH + h) * DH + tid] = nr * dec + DN[(size_t)unit * 128 + tid] * inw;
        if (tid == 0) a.out[O_PM + (l * NBATCH + b) * NH + h] = mn;
    }
#pragma unroll
    for (int j = 0; j < 8; ++j) { const int idx = 2048 * j + 4 * tid, e = idx >> 7, d = idx & 127; v2u pk; pk.x = pk2(cr[j].x, cr[j].y); pk.y = pk2(cr[j].z, cr[j].w); *(LAS v2u*)(C0 + e * CS + d) = pk; }
    if (tid < 128) C0[128 * CS + tid] = (bf16)f2bf(nr);
    for (int i = tid; i < 15 * CS; i += NTHREADS) C0[129 * CS + i] = 0;
    { v4u vr[8]; img_load(Z + 1024 + hq, row0, vr, tid); img_store<false>(VIMG, vr, wS, tid); }
    v4u kr[8]; img_load(Z + 512 + hq, row0, kr, tid);
    __syncthreads();
    bf16x8_t qf[2][4];
#pragma unroll
    for (int tt = 0; tt < 2; ++tt)
#pragma unroll
        for (int kk = 0; kk < 4; ++kk) qf[tt][kk] = *(const bf16x8_t*)(Z + (size_t)(row0 + 32 * w + 16 * tt + fr) * NZ + hq + 32 * kk + 8 * g);
    float MxT[2];
#pragma unroll
    for (int tt = 0; tt < 2; ++tt) MxT[tt] = fmaxf(gS[32 * w + 16 * tt + fr], m0);
    f32x4 O[2][9];
#pragma unroll
    for (int tt = 0; tt < 2; ++tt)
#pragma unroll
        for (int n = 0; n < 9; ++n) O[tt][n] = (f32x4){0.f, 0.f, 0.f, 0.f};
#pragma unroll
    for (int kk = 0; kk < 4; ++kk)
#pragma unroll
        for (int n = 0; n < 9; ++n) { const bf16x8_t cf = *(const LAS bf16x8_t*)(C0 + (16 * n + fr) * CS + 32 * kk + 8 * g);
#pragma unroll
            for (int tt = 0; tt < 2; ++tt) O[tt][n] = __builtin_amdgcn_mfma_f32_16x16x32_bf16(qf[tt][kk], cf, O[tt][n], 0, 0, 0); }
#pragma unroll
    for (int tt = 0; tt < 2; ++tt)
#pragma unroll
        for (int i = 0; i < 4; ++i) { const float sc = fexp(m0 - fmaxf(gS[32 * w + 16 * tt + 4 * g + i], m0));
#pragma unroll
            for (int n = 0; n < 9; ++n) O[tt][n][i] *= sc; }
    __syncthreads();
    img_store<false>(KIMG, kr, wS, tid);
    __syncthreads();
    float denT[2] = {0.f, 0.f};
    for (int kb = 0; kb <= w; ++kb) {
        bf16x8_t pa[2];
#pragma unroll
        for (int st = 0; st < 2; ++st) {
            bf16x8_t kf[4];
#pragma unroll
            for (int kk = 0; kk < 4; ++kk) kf[kk] = *(const LAS bf16x8_t*)(KIMG + off_b(32 * kb + 8 * (fr >> 2) + 4 * st + (fr & 3), 4 * kk + g));
            const f32x4 us = *(const LAS f32x4*)(uS + 32 * kb + 8 * g + 4 * st);
#pragma unroll
            for (int tt = 0; tt < 2; ++tt) { f32x4 sT = (f32x4){0.f, 0.f, 0.f, 0.f};
#pragma unroll
                for (int kk = 0; kk < 4; ++kk) sT = __builtin_amdgcn_mfma_f32_16x16x32_bf16(kf[kk], qf[tt][kk], sT, 0, 0, 0);
                const int t = 32 * w + 16 * tt + fr;
#pragma unroll
                for (int i = 0; i < 4; ++i) { const int s = 32 * kb + 8 * g + 4 * st + i; const float p = (s <= t) ? sT[i] * fexp(us[i] - MxT[tt]) : 0.f; denT[tt] += p; pa[tt][4 * st + i] = (short)f2bf(p); } }
        }
#pragma unroll
        for (int n = 0; n < 8; ++n) { const bf16x8_t vf = tr_frag(VIMG, lane, n, kb);
#pragma unroll
            for (int tt = 0; tt < 2; ++tt) O[tt][n] = __builtin_amdgcn_mfma_f32_16x16x32_bf16(pa[tt], vf, O[tt][n], 0, 0, 0); }
    }
    float dsum[2];
#pragma unroll
    for (int tt = 0; tt < 2; ++tt) { float d = denT[tt]; d += __shfl_xor(d, 16); d += __shfl_xor(d, 32); dsum[tt] = d; }
    float gm[8];
#pragma unroll
    for (int n = 0; n < 8; ++n) gm[n] = inp(a, I_GMO)[l * 512 + hq + 16 * n + fr];
#pragma unroll
    for (int tt = 0; tt < 2; ++tt)
#pragma unroll
        for (int i = 0; i < 4; ++i) { const int t = 32 * w + 16 * tt + 4 * g + i;
            const float den = __shfl(O[tt][8][i], lane & 48) + __shfl(dsum[tt], 4 * g + i);
            const float mt = bS[t] + fmaxf(gS[t], m0), rden = frcp(fmaxf(fabsf(den), fexp(-mt)));
            float hv[8], ss = 0.f;
#pragma unroll
            for (int n = 0; n < 8; ++n) { hv[n] = O[tt][n][i] * rden; ss += hv[n] * hv[n]; }
            ss += __shfl_xor(ss, 1); ss += __shfl_xor(ss, 2); ss += __shfl_xor(ss, 4); ss += __shfl_xor(ss, 8);
            const float inv = frsq(ss * (1.f / DH) + EPS);
            if (t < nvalid) { const unsigned row = (unsigned)(row0 + t);
#pragma unroll
                for (int n = 0; n < 8; ++n) { const unsigned col = hq + 16 * n + fr; const float og = bf2f(Z[row * NZ + 1536 + col]);
                    MIX[row * D + col] = (bf16)f2bf(hv[n] * inv * gm[n] * fsigmoid(og)); } } }
    __syncthreads();
}

__device__ __forceinline__ void mlstm_sample_unit(const Ctx& a, int l, int item, LAS unsigned char* lds, int tid) {
    const int lane = tid & 63, w = __builtin_amdgcn_readfirstlane(tid >> 6);
    const int b = item >> 2, h = item & 3, hq = h * DH, row0 = R_SAMPLE + b * DEC_T;
    const bf16* Z = (const bf16*)(a.ws + WS_HZ); const float* G = (const float*)(a.ws + WS_G); bf16* MIX = (bf16*)(a.ws + WS_MIX);
    LAS float* qS = (LAS float*)lds; LAS float* kS = qS + 512; LAS float* vS = kS + 512; LAS float* numS = vS + 512; LAS float* redD = numS + 512; LAS float* redS = redD + 8; LAS float* mtS = redS + 8;
    { const int t = tid >> 7, e = tid & 127; const bf16* zr = Z + (size_t)(row0 + t) * NZ + hq + e; qS[tid] = bf2f(zr[0]); kS[tid] = bf2f(zr[512]); vS[tid] = bf2f(zr[1024]); }
    const size_t sidx = (size_t)(l * DEC_B + b) * NH + h;
    float m = inp(a, I_SM)[sidx]; const float big = inp(a, I_BG)[l * 8 + h], bfg = inp(a, I_BG)[l * 8 + 4 + h];
    float dec[4], igw[4];
#pragma unroll
    for (int t = 0; t < 4; ++t) { const float ig = G[(size_t)(row0 + t) * 8 + h] + big, fg = G[(size_t)(row0 + t) * 8 + 4 + h] + bfg, logf = -softplus_f(-fg);
        const float mn = fmaxf(logf + m, ig); dec[t] = expf(logf + m - mn); igw[t] = expf(ig - mn); m = mn; if (tid == 0) mtS[t] = mn; }
    f32x4 cr[8]; { const f32x4* C0 = (const f32x4*)(inp(a, I_SC) + sidx * 16384) + tid;
#pragma unroll
      for (int j = 0; j < 8; ++j) cr[j] = C0[512 * j]; }
    float nr = tid < 128 ? inp(a, I_SN)[sidx * 128 + tid] : 0.f;
    __syncthreads();
    const int d0 = 4 * (tid & 31), e0 = tid >> 5;
#pragma unroll
    for (int t = 0; t < 4; ++t) { const f32x4 kv = *(const LAS f32x4*)(kS + 128 * t + d0), qv = *(const LAS f32x4*)(qS + 128 * t + d0);
#pragma unroll
        for (int j = 0; j < 8; ++j) { const float iv = igw[t] * vS[128 * t + e0 + 16 * j]; cr[j] = cr[j] * dec[t] + kv * iv;
            float p = (cr[j].x * qv.x + cr[j].y * qv.y) + (cr[j].z * qv.z + cr[j].w * qv.w);
            p += __shfl_xor(p, 1); p += __shfl_xor(p, 2); p += __shfl_xor(p, 4); p += __shfl_xor(p, 8); p += __shfl_xor(p, 16);
            if ((tid & 31) == 0) numS[128 * t + e0 + 16 * j] = p; }
        if (w < 2) { nr = dec[t] * nr + igw[t] * kS[128 * t + tid]; float pd = wave_sum(nr * qS[128 * t + tid]); if (lane == 0) redD[2 * t + w] = pd; } }
    { f32x4* dst = (f32x4*)(a.out + O_SC + sidx * 16384) + tid;
#pragma unroll
      for (int j = 0; j < 8; ++j) dst[512 * j] = cr[j]; }
    if (tid < 128) a.out[O_SN + sidx * 128 + tid] = nr;
    if (tid == 0) a.out[O_SM + sidx] = m;
    __syncthreads();
    const int t = tid >> 7, e = tid & 127;
    const float den = redD[2 * t] + redD[2 * t + 1], hv = numS[tid] / fmaxf(fabsf(den), expf(-mtS[t]));
    const float sq = wave_sum(hv * hv); if (lane == 0) redS[w] = sq;
    __syncthreads();
    const float ss = redS[2 * t] + redS[2 * t + 1];
    const float og = bf2f(Z[(size_t)(row0 + t) * NZ + 1536 + hq + e]);
    MIX[(size_t)(row0 + t) * D + hq + e] = (bf16)f2bf(hv * (1.0f / sqrtf(ss * (1.f / DH) + EPS)) * inp(a, I_GMO)[l * 512 + hq + e] * sigmoid_f(og));
    __syncthreads();
}

constexpr int N_PHASES = 23;
constexpr int TAB_OFF = MISC_OFF + 128;
static_assert(TAB_OFF + 256 <= LDS_BYTES, "LDS map");
__global__ void __launch_bounds__(NTHREADS, 2) mega_fwd(Args args) {
    extern __shared__ __attribute__((aligned(16))) unsigned char lds_raw[];
    LAS unsigned char* lds = (LAS unsigned char*)lds_raw;
    volatile LAS unsigned* MISC = (volatile LAS unsigned*)(lds + MISC_OFF);
    const int tid0 = threadIdx.x;
    for (int u = tid0; u < (LDS_BYTES - LDSCTL_OFF) / 4; u += NTHREADS) ((LAS unsigned*)(lds + LDSCTL_OFF))[u] = 0u;
    __syncthreads();
    if (tid0 == 0) {
        volatile LAS unsigned* tab = (volatile LAS unsigned*)(lds + TAB_OFF);
#pragma unroll
        for (int i = 0; i < 30; ++i) { const unsigned long long v = (unsigned long long)args.in[i]; tab[2 * i] = (unsigned)v; tab[2 * i + 1] = (unsigned)(v >> 32); }
    }
    __syncthreads();
    XcdBarrier bar; bar.bar = (unsigned*)(args.ws + WS_CTL) + CW_BAR; bar.x = 0; bar.st = nullptr;
    if ((args.ph_hi - args.ph_lo) > 1) bar = xcd_barrier_post((unsigned*)(args.ws + WS_CTL) + CW_BAR, MISC + 8);

#ifndef PROBE_DUP
#define PROBE_DUP 0
#endif
    for (int pp = 2 * args.ph_lo; pp < 2 * args.ph_hi; ++pp) {
        const int p = pp >> 1;
        if (pp & 1) { if (p == 0 || !((PROBE_DUP >> ((p - 1) % 11)) & 1)) continue; }
        if (pp > 2 * args.ph_lo) { XcdBarrier b2 = bar; asm volatile("" : "+s"(b2.bar), "+s"(b2.x)); xcd_barrier(b2); }
        Ctx cx; { unsigned tv = (unsigned)(size_t)(lds + TAB_OFF); asm volatile("" : "+v"(tv)); cx.tab = (volatile LAS unsigned*)(size_t)tv; } cx.out = args.out; cx.ws = args.ws;
        int G = gridDim.x, bx = blockIdx.x, tid = tid0;
        asm volatile("" : "+s"(cx.out), "+s"(cx.ws), "+s"(G), "+s"(bx), "+v"(tid));
        unsigned char* ws = cx.ws;
        const int lane = tid & 63, wave = __builtin_amdgcn_readfirstlane(tid >> 6);
        const int vcu = (G % 8 == 0) ? (bx % 8) * (G / 8) + bx / 8 : bx;
        const int gw = vcu * NWAVES + wave, NGW = G * NWAVES;
        bf16* XN = (bf16*)(ws + WS_XN); bf16* MIX = (bf16*)(ws + WS_MIX); bf16* HZ = (bf16*)(ws + WS_HZ); float* GATES = (float*)(ws + WS_G);
        const pg8::XRows XR{cx.out, (float*)(ws + WS_XTAIL)};
        if (p == 0) {
            LAS float* scr = (LAS float*)(lds + wave * 16384);
            for (int it = gw; it < 2 * IT_LAYER; it += NGW) conv_dispatch(cx, it, scr, lane);
            for (int it = gw; it < 2 * 8 * 2 * 8; it += NGW) {
                const int fk = it & 7, mat = (it >> 3) & 1, lw = it >> 4, n = fk >> 1, kk = fk & 1;
                const float* src = inp(cx, mat ? I_WRX : I_WRA) + (size_t)lw * 4096; v4u o;
                const int dd = 32 * kk + 8 * (lane >> 4), e = 16 * n + (lane & 15);
                o.x = pk2(src[(dd + 0) * 64 + e], src[(dd + 1) * 64 + e]); o.y = pk2(src[(dd + 2) * 64 + e], src[(dd + 3) * 64 + e]);
                o.z = pk2(src[(dd + 4) * 64 + e], src[(dd + 5) * 64 + e]); o.w = pk2(src[(dd + 6) * 64 + e], src[(dd + 7) * 64 + e]);
                ((v4u*)(ws + WS_WGF))[(size_t)it * 64 + lane] = o;
            }
            for (int r = gw; r < MP; r += NGW) {
                float* xo = xrow_ptr(cx, r);
                if (r < N_REAL) {
                    const float* src = r < R_SAMPLE ? inp(cx, I_XP) + (size_t)r * D : (r < R_META ? inp(cx, I_XS) + (size_t)(r - R_SAMPLE) * D : inp(cx, I_META) + (size_t)(r - R_META) * D);
#pragma unroll
                    for (int j = 0; j < 4; ++j) ((f32x4*)xo)[lane + 64 * j] = ((const f32x4*)src)[lane + 64 * j];
                    norm_row_to_bf16(src, XN + (size_t)r * D, lane);
                } else {
#pragma unroll
                    for (int j = 0; j < 4; ++j) ((f32x4*)xo)[lane + 64 * j] = (f32x4){0.f, 0.f, 0.f, 0.f};
                    for (int j = 0; j < 2; ++j) { ((v4u*)(XN + (size_t)r * D))[lane + 64 * j] = (v4u){0u, 0u, 0u, 0u}; ((v4u*)(MIX + (size_t)r * D))[lane + 64 * j] = (v4u){0u, 0u, 0u, 0u}; }
                }
            }
            continue;
        }
        const int l = (p - 1) / 11, k = (p - 1) % 11;
        const unsigned char* wb = ws + WS_WB + (size_t)l * LW_SIZE;
        if (k == 0 || k == 8) {
            pg8::Gemm g{XN, (const bf16*)(wb + (k == 0 ? LW_U1 : LW_U2)), MP, NUP, D}; pg8::StaticOrder S; S.init(MP, NUP, G, bx);
            pg8::EpiSwiGLU E{HZ, DFF};
            pg8::gemm_phase<pg8::EpiSwiGLU, pg8::StaticOrder, true, true>(lds, g, S, E, tid);
        } else if (k == 1 || k == 9) {
            pg8::Gemm g{HZ, (const bf16*)(wb + (k == 1 ? LW_D1 : LW_D2)), MP, D, DFF}; pg8::StaticOrder S; S.init(MP, D, G, bx);
            pg8::EpiResid E{XR, 0.5f};
            pg8::gemm_phase<pg8::EpiResid, pg8::StaticOrder, true, true>(lds, g, S, E, tid);
        } else if (k == 6) {
            pg8::Gemm g{MIX, (const bf16*)(wb + LW_O), MP, D, D}; pg8::StaticOrder S; S.init(MP, D, G, bx);
            pg8::EpiResid E{XR, 1.0f};
            pg8::gemm_phase<pg8::EpiResid, pg8::StaticOrder, true, true>(lds, g, S, E, tid);
        } else if (k == 3) {
            pg8::Gemm g{XN, (const bf16*)(wb + LW_IN), MP, NWIN, D}; pg8::StaticOrder S; S.init(MP, NWIN, G, bx);
            pg8::EpiZ E{HZ, GATES};
            pg8::gemm_phase<pg8::EpiZ, pg8::StaticOrder, true, true>(lds, g, S, E, tid);
        } else if (k == 2 || k == 7 || (k == 10 && l == 0)) {
            for (int r = gw; r < MP; r += NGW) norm_row_to_bf16(xrow_ptr(cx, r), XN + (size_t)r * D, lane);
        } else if (k == 10) {
            const float* gfin = inp(cx, I_GFIN);
            for (int r = gw; r < R_META; r += NGW) {
                f32x4* xr = (f32x4*)xrow_ptr(cx, r) + lane; const f32x4* gf = (const f32x4*)gfin + lane; f32x4 v[4]; float s = 0.f;
#pragma unroll
                for (int j = 0; j < 4; ++j) { v[j] = xr[64 * j]; s += (v[j].x * v[j].x + v[j].y * v[j].y) + (v[j].z * v[j].z + v[j].w * v[j].w); }
                const float rstd = 1.f / sqrtf(wave_sum(s) * (1.f / D) + EPS);
#pragma unroll
                for (int j = 0; j < 4; ++j) xr[64 * j] = v[j] * rstd * gf[64 * j];
            }
        } else if (k == 4) {
#ifndef PROBE_ITEM
#define PROBE_ITEM 0
#endif
            constexpr int NA = ML_UNITS + LRU_UNITS + DEC_B * NH;
            constexpr int DA0 = (PROBE_ITEM & 1) ? 0 : ((PROBE_ITEM & 2) ? ML_UNITS : ML_UNITS + LRU_UNITS), DAN = (PROBE_ITEM & 1) ? ML_UNITS : ((PROBE_ITEM & 2) ? LRU_UNITS : ((PROBE_ITEM & 4) ? DEC_B * NH : 0));
            for (int it0 = vcu; it0 < NA + DAN; it0 += G) {
                const int it = it0 < NA ? it0 : DA0 + (it0 - NA);
                int ll = l, t2 = tid; asm volatile("" : "+s"(ll), "+v"(t2));
                if (it < ML_UNITS) mlstm_unit<0>(cx, ll, it, lds, t2);
                else if (it < ML_UNITS + LRU_UNITS) lru_unit<0>(cx, ll, it - ML_UNITS, lds, t2);
                else mlstm_sample_unit(cx, ll, it - ML_UNITS - LRU_UNITS, lds, t2);
            }
        } else if (k == 5) {
            constexpr int NC = ML_UNITS + LRU_UNITS + DEC_B / 16;
            constexpr int DC0 = (PROBE_ITEM & 8) ? 0 : ((PROBE_ITEM & 16) ? ML_UNITS : ML_UNITS + LRU_UNITS), DCN = (PROBE_ITEM & 8) ? ML_UNITS : ((PROBE_ITEM & 16) ? LRU_UNITS : ((PROBE_ITEM & 32) ? DEC_B / 16 : 0));
            for (int it0 = vcu; it0 < NC + DCN; it0 += G) {
                const int it = it0 < NC ? it0 : DC0 + (it0 - NC);
                int ll = l, t2 = tid; asm volatile("" : "+s"(ll), "+v"(t2));
                if (it < ML_UNITS) mlstm_unit<1>(cx, ll, it, lds, t2);
                else if (it < ML_UNITS + LRU_UNITS) lru_unit<1>(cx, ll, it - ML_UNITS, lds, t2);
                else lru_unit<1, true>(cx, ll, it - ML_UNITS - LRU_UNITS, lds, t2);
            }
        }
    }
}

extern "C" void kernel_launch(void* const* d_in, const int* in_sizes, int n_in, void* d_out, int out_size, void* d_ws, size_t ws_size, hipStream_t stream) {
    static int grid = 0;
    if (grid == 0) {
        if (n_in != 30 || out_size != (int)O_END || ws_size < WS_END) { fprintf(stderr, "kernel_launch: unexpected shapes: n_in %d out %d ws %zu\n", n_in, out_size, ws_size); grid = -1; return; }
        int dev = 0, cus = 0, per_cu = 0;
        if (hipGetDevice(&dev) != hipSuccess || hipDeviceGetAttribute(&cus, hipDeviceAttributeMultiprocessorCount, dev) != hipSuccess) { grid = -1; return; }
        if (hipFuncSetAttribute((const void*)mega_fwd, hipFuncAttributeMaxDynamicSharedMemorySize, LDS_BYTES) != hipSuccess) { fprintf(stderr, "kernel_launch: hipFuncSetAttribute failed\n"); grid = -1; return; }
        if (hipOccupancyMaxActiveBlocksPerMultiprocessor(&per_cu, (const void*)mega_fwd, NTHREADS, LDS_BYTES) != hipSuccess || per_cu < 1)
            fprintf(stderr, "kernel_launch: note: occupancy query reports %d workgroups per CU\n", per_cu);
        (void)hipGetLastError();
        grid = cus;
    }
    if (grid < 0) return;
    if (hipMemsetAsync((char*)d_ws + WS_CTL, 0, CTL_ZERO_BYTES, stream) != hipSuccess) { fprintf(stderr, "kernel_launch: hipMemsetAsync failed\n"); return; }
    Args a{};
    for (int i = 0; i < 30; ++i) a.in[i] = (const float*)d_in[i];
    a.out = (float*)d_out; a.ws = (unsigned char*)d_ws;
#if MK_ONE_LAUNCH
    a.ph_lo = 0; a.ph_hi = N_PHASES; a.li = 0;
    hipLaunchKernelGGL(mega_fwd, dim3(grid), dim3(NTHREADS), LDS_BYTES, stream, a);
#else
    for (int p = 0; p < N_PHASES; ++p) { a.ph_lo = p; a.ph_hi = p + 1; a.li = p; hipLaunchKernelGGL(mega_fwd, dim3(grid), dim3(NTHREADS), LDS_BYTES, stream, a); }
#endif
}
```
